# Optimizing an MI355X kernel written in HIP

```python
import math
import jax, jax.numpy as jnp
from jax import lax
import numpy as np

D_MODEL = 1024
BATCH = 8
SEQ = 2048
DEPTH = 2

HEAD_DIM = 64
N_DIFF_HEADS = 8
DIFF_QK_DIM = 32
N_NA_HEADS = 8
DIFF_QK_W = N_DIFF_HEADS * 2 * DIFF_QK_DIM
DIFF_V_W = N_DIFF_HEADS * HEAD_DIM
NA_W = N_NA_HEADS * HEAD_DIM
MIX_WIDTH = DIFF_V_W + NA_W
IN_PROJ_W = 2 * DIFF_QK_W + DIFF_V_W + 3 * NA_W
GRID_W = 64
NA_WIN_H = 8
NA_WIN_W = 16
T5_BUCKETS = 32
T5_MAX_EXACT = 8
T5_MAX_DIST = 128
Q_BLOCK = 128
PEER_HEADS = 8
PEER_N_KEYS = 128
PEER_N_EXPERTS = PEER_N_KEYS * PEER_N_KEYS
PEER_KEY_DIM = 256
PEER_TOPK = 16
PEER_CHUNK = 128
LN_EPS = 1e-5
NEG_INF = -1e30

kernel_name = "hymba_diff_natten_peer_deepnorm_encoder"


def layer_norm(x, g, b):
    xf = x.astype(jnp.float32)
    mu = jnp.mean(xf, axis=-1, keepdims=True)
    var = jnp.mean(jnp.square(xf - mu), axis=-1, keepdims=True)
    y = (xf - mu) * lax.rsqrt(var + LN_EPS) * g.astype(jnp.float32) + b.astype(jnp.float32)
    return y.astype(x.dtype)


def rms_norm(x, g):
    xf = x.astype(jnp.float32)
    y = xf * lax.rsqrt(jnp.mean(jnp.square(xf), axis=-1, keepdims=True) + LN_EPS) * g.astype(jnp.float32)
    return y.astype(x.dtype)


def t5_bucket(rel):
    half = T5_BUCKETS // 2
    base = jnp.where(rel > 0, half, 0)
    n = jnp.abs(rel)
    nf = jnp.maximum(n, 1).astype(jnp.float32)
    large = T5_MAX_EXACT + (jnp.log(nf / T5_MAX_EXACT) / math.log(T5_MAX_DIST / T5_MAX_EXACT)
                            * (half - T5_MAX_EXACT)).astype(jnp.int32)
    large = jnp.minimum(large, half - 1)
    return base + jnp.where(n < T5_MAX_EXACT, n, large)


def diff_attention(q, k, v, lam, lam_init, norm_g, t5_bias):
    B, S, H, _, dk = q.shape
    dv = v.shape[-1]
    nb = S // Q_BLOCK
    q = q.transpose(3, 0, 2, 1, 4)
    k = k.transpose(3, 0, 2, 1, 4)
    v = v.transpose(0, 2, 1, 3)
    qb = q.reshape(2, B, H, nb, Q_BLOCK, dk).transpose(3, 0, 1, 2, 4, 5)
    kpos = jnp.arange(S, dtype=jnp.int32)
    scale = DIFF_QK_DIM ** -0.5

    def block(args):
        qblk, bi = args
        qpos = bi * Q_BLOCK + jnp.arange(Q_BLOCK, dtype=jnp.int32)
        bias = t5_bias[t5_bucket(kpos[None, :] - qpos[:, None])]
        bias = bias.transpose(2, 0, 1).astype(jnp.float32)
        s = jnp.einsum('mbhqd,mbhkd->mbhqk', qblk, k).astype(jnp.float32) * scale + bias
        a = jax.nn.softmax(s, axis=-1)
        w = a[0] - lam * a[1]
        return jnp.einsum('bhqk,bhkd->bhqd', w.astype(v.dtype), v)

    o = lax.map(block, (qb, jnp.arange(nb, dtype=jnp.int32)))
    o = o.transpose(1, 2, 0, 3, 4).reshape(B, H, S, dv)
    o = rms_norm(o, norm_g) * (1.0 - lam_init)
    return o.transpose(0, 2, 1, 3).reshape(B, S, H * dv)


def neighborhood_attention(q, k, v, rpb):
    B, S, H, d = q.shape
    rows = S // GRID_W
    kh = min(NA_WIN_H, rows)

    def grid(t):
        return t.reshape(B, rows, GRID_W, H, d).transpose(0, 3, 1, 2, 4)

    q, k, v = grid(q), grid(k), grid(v)
    r = jnp.arange(rows, dtype=jnp.int32)
    row_idx = jnp.clip(r - kh // 2, 0, rows - kh)[:, None] + jnp.arange(kh, dtype=jnp.int32)[None, :]
    k_rows = k[:, :, row_idx]
    v_rows = v[:, :, row_idx]
    c = jnp.arange(GRID_W, dtype=jnp.int32)
    col_start = jnp.clip(c - NA_WIN_W // 2, 0, GRID_W - NA_WIN_W)
    in_win = (c[None, :] >= col_start[:, None]) & (c[None, :] < col_start[:, None] + NA_WIN_W)
    dr = row_idx - r[:, None] + (NA_WIN_H - 1)
    dc = jnp.clip(c[None, :] - c[:, None] + (NA_WIN_W - 1), 0, 2 * NA_WIN_W - 2)
    bias = rpb[:, dr[:, None, :, None], dc[None, :, None, :]].astype(jnp.float32)
    bias = jnp.where(in_win[None, None, :, None, :], bias, NEG_INF)
    s = jnp.einsum('bhrqd,bhrikd->bhrqik', q, k_rows).astype(jnp.float32) * (d ** -0.5) + bias
    p = jax.nn.softmax(s.reshape(B, H, rows, GRID_W, kh * GRID_W), axis=-1).reshape(s.shape)
    o = jnp.einsum('bhrqik,bhrikd->bhrqd', p.astype(v.dtype), v_rows)
    return o.transpose(0, 2, 3, 1, 4).reshape(B, S, H * d)


def hybrid_mixer(x, w_in, w_out, lq1, lk1, lq2, lk2, lam_init, norm_g, t5_bias, rpb):
    B, S, _ = x.shape
    proj = x @ w_in
    o1 = DIFF_QK_W
    o2 = o1 + DIFF_QK_W
    o3 = o2 + DIFF_V_W
    o4 = o3 + NA_W
    o5 = o4 + NA_W
    dq = proj[..., :o1].reshape(B, S, N_DIFF_HEADS, 2, DIFF_QK_DIM)
    dk = proj[..., o1:o2].reshape(B, S, N_DIFF_HEADS, 2, DIFF_QK_DIM)
    dv = proj[..., o2:o3].reshape(B, S, N_DIFF_HEADS, HEAD_DIM)
    nq = proj[..., o3:o4].reshape(B, S, N_NA_HEADS, HEAD_DIM)
    nk = proj[..., o4:o5].reshape(B, S, N_NA_HEADS, HEAD_DIM)
    nv = proj[..., o5:].reshape(B, S, N_NA_HEADS, HEAD_DIM)
    lam = (jnp.exp(jnp.sum(lq1.astype(jnp.float32) * lk1.astype(jnp.float32)))
           - jnp.exp(jnp.sum(lq2.astype(jnp.float32) * lk2.astype(jnp.float32))) + lam_init)
    o_diff = diff_attention(dq, dk, dv, lam, lam_init, norm_g, t5_bias)
    o_na = neighborhood_attention(nq, nk, nv, rpb)
    return jnp.concatenate([o_diff, o_na], axis=-1) @ w_out


def peer_ffn(x, wq, keys, u_tab, v_tab):
    B, S, D = x.shape
    T = B * S
    xf = x.reshape(T, D)
    q = (xf @ wq).reshape(T, PEER_HEADS, 2, PEER_KEY_DIM // 2).astype(jnp.float32)
    kf = keys.astype(jnp.float32)
    s1 = jnp.einsum('thd,kd->thk', q[:, :, 0], kf[0])
    s2 = jnp.einsum('thd,kd->thk', q[:, :, 1], kf[1])
    v1, i1 = lax.top_k(s1, PEER_TOPK)
    v2, i2 = lax.top_k(s2, PEER_TOPK)
    cand = (v1[..., :, None] + v2[..., None, :]).reshape(T, PEER_HEADS, PEER_TOPK * PEER_TOPK)
    sc, ci = lax.top_k(cand, PEER_TOPK)
    e1 = jnp.take_along_axis(i1, ci // PEER_TOPK, axis=-1)
    e2 = jnp.take_along_axis(i2, ci % PEER_TOPK, axis=-1)
    idx = e1 * PEER_N_KEYS + e2
    g = jax.nn.softmax(sc, axis=-1)
    nc = T // PEER_CHUNK

    def chunk(args):
        xc, ic, gc = args
        u = u_tab[ic]
        h = jax.nn.gelu(jnp.einsum('chkd,cd->chk', u, xc).astype(jnp.float32), approximate=False)
        w = (gc * h).astype(x.dtype)
        return jnp.einsum('chk,chkd->cd', w, v_tab[ic])

    out = lax.map(chunk, (xf.reshape(nc, PEER_CHUNK, D),
                          idx.reshape(nc, PEER_CHUNK, PEER_HEADS, PEER_TOPK),
                          g.reshape(nc, PEER_CHUNK, PEER_HEADS, PEER_TOPK)))
    return out.reshape(B, S, D)


def setup_inputs(seed: int = 0) -> dict:
    key = jax.random.key(seed)
    ks = jax.random.split(key, 20)
    beta = (8 * DEPTH) ** -0.25
    nrm = jax.random.normal
    x = nrm(ks[0], (BATCH, SEQ, D_MODEL), jnp.float32)
    col_scale = jnp.concatenate([jnp.ones((2 * DIFF_QK_W,), jnp.float32),
                                 jnp.full((DIFF_V_W,), beta, jnp.float32),
                                 jnp.ones((2 * NA_W,), jnp.float32),
                                 jnp.full((NA_W,), beta, jnp.float32)])
    w_in = nrm(ks[1], (DEPTH, D_MODEL, IN_PROJ_W), jnp.float32) * (D_MODEL ** -0.5) * col_scale
    w_out = nrm(ks[2], (DEPTH, MIX_WIDTH, D_MODEL), jnp.float32) * (MIX_WIDTH ** -0.5) * beta
    lam_q1 = nrm(ks[3], (DEPTH, DIFF_QK_DIM), jnp.float32) * 0.1
    lam_k1 = nrm(ks[4], (DEPTH, DIFF_QK_DIM), jnp.float32) * 0.1
    lam_q2 = nrm(ks[5], (DEPTH, DIFF_QK_DIM), jnp.float32) * 0.1
    lam_k2 = nrm(ks[6], (DEPTH, DIFF_QK_DIM), jnp.float32) * 0.1
    diff_norm_g = 1.0 + 0.02 * nrm(ks[7], (DEPTH, HEAD_DIM), jnp.float32)
    t5_bias = 0.1 * nrm(ks[8], (T5_BUCKETS, N_DIFF_HEADS), jnp.float32)
    na_rpb = 0.1 * nrm(ks[9], (DEPTH, N_NA_HEADS, 2 * NA_WIN_H - 1, 2 * NA_WIN_W - 1), jnp.float32)
    ln1_g = 1.0 + 0.02 * nrm(ks[10], (DEPTH, D_MODEL), jnp.float32)
    ln1_b = 0.02 * nrm(ks[11], (DEPTH, D_MODEL), jnp.float32)
    peer_wq = nrm(ks[12], (DEPTH, D_MODEL, PEER_HEADS * PEER_KEY_DIM), jnp.float32) * (D_MODEL ** -0.5)
    peer_keys = nrm(ks[13], (DEPTH, 2, PEER_N_KEYS, PEER_KEY_DIM // 2), jnp.float32) * ((PEER_KEY_DIM // 2) ** -0.5)
    peer_u = nrm(ks[14], (DEPTH, PEER_N_EXPERTS, D_MODEL), jnp.float32) * (D_MODEL ** -0.5)
    peer_v = nrm(ks[15], (DEPTH, PEER_N_EXPERTS, D_MODEL), jnp.float32) * beta
    ln2_g = 1.0 + 0.02 * nrm(ks[16], (DEPTH, D_MODEL), jnp.float32)
    ln2_b = 0.02 * nrm(ks[17], (DEPTH, D_MODEL), jnp.float32)
    return {"x": x, "w_in": w_in, "w_out": w_out, "lam_q1": lam_q1, "lam_k1": lam_k1,
            "lam_q2": lam_q2, "lam_k2": lam_k2, "diff_norm_g": diff_norm_g, "t5_bias": t5_bias,
            "na_rpb": na_rpb, "ln1_g": ln1_g, "ln1_b": ln1_b, "peer_wq": peer_wq,
            "peer_keys": peer_keys, "peer_u": peer_u, "peer_v": peer_v,
            "ln2_g": ln2_g, "ln2_b": ln2_b}


def reference(x, w_in, w_out, lam_q1, lam_k1, lam_q2, lam_k2, diff_norm_g, t5_bias,
              na_rpb, ln1_g, ln1_b, peer_wq, peer_keys, peer_u, peer_v, ln2_g, ln2_b):
    alpha = (2 * DEPTH) ** 0.25
    for l in range(DEPTH):
        lam_init = 0.8 - 0.6 * math.exp(-0.3 * l)
        h = hybrid_mixer(x, w_in[l], w_out[l], lam_q1[l], lam_k1[l], lam_q2[l], lam_k2[l],
                         lam_init, diff_norm_g[l], t5_bias, na_rpb[l])
        x = layer_norm(alpha * x + h, ln1_g[l], ln1_b[l])
        f = peer_ffn(x, peer_wq[l], peer_keys[l], peer_u[l], peer_v[l])
        x = layer_norm(alpha * x + f, ln2_g[l], ln2_b[l])
    return x
```

```cpp
#define MK_N_LAUNCHES 13
#include <hip/hip_runtime.h>
#include <cstdio>
#include <cstdint>
#include <cmath>
namespace pg8 {
#define PG8_LAS __attribute__((address_space(3)))
typedef unsigned short bf16_t;
typedef short bf16x8 __attribute__((ext_vector_type(8)));
typedef float f32x4 __attribute__((ext_vector_type(4)));
typedef unsigned u32x4 __attribute__((ext_vector_type(4)));
constexpr int BM = 256, BK = 64, HALF = 128, HTB = HALF * BK * 2  , STAGE_BYTES = 8 * HTB, NXCD = 8, WGM = 8;

__host__ __device__ __forceinline__ int lds_byte(int r, int c) { const int st = (r >> 4) * 2 + (c >> 5), rr = r & 15, cc = c & 31, ob = rr * 64 + cc * 2; return st * 1024 + (ob ^ (((ob >> 9) & 1) << 5)); }
__host__ __device__ __forceinline__ void stage_rc(int b, int& R, int& C) { const int st = b / 1024, sb = b % 1024, swz = sb ^ (((sb >> 9) & 1) << 5); R = (st >> 1) * 16 + swz / 64; C = (st & 1) * 32 + (swz % 64) / 2; }
__host__ __device__ __forceinline__ int perm32(int rho) { const int n = rho >> 4, i = rho & 15; return 8 * (i >> 2) + 4 * n + (i & 3); }

struct Unit { int pm, pn; };
struct Gemm { const bf16_t* A; const bf16_t* Bt; int M, N, K; };

struct StaticOrder {
    int nM, nN, nwg, G, c;
    __host__ __device__ void init(int M, int N, int G_, int c_) { nM = M / BM; nN = N / BM; nwg = nM * nN; G = G_; c = c_; }
    __host__ __device__ bool next(int i, Unit& u) const {
        const long L = (long)i * G + c; if (L >= nwg) return false;
        int wgid = (int)L; { const int q = nwg / NXCD, r = nwg % NXCD, xcd = wgid % NXCD, off = wgid / NXCD; wgid = (xcd < r ? xcd * (q + 1) : r * (q + 1) + (xcd - r) * q) + off; }
        const int nig = WGM * nN, gid = wgid / nig, fm = gid * WGM, gsz = (nM - fm) < WGM ? (nM - fm) : WGM;
        u.pm = fm + ((wgid % nig) % gsz); u.pn = (wgid % nig) / gsz; return true;
    }
    __device__ __forceinline__ void a_ready(const Unit&) const {}
    __device__ __forceinline__ void done(const Unit&) const {}
};

__device__ __forceinline__ unsigned cvt_pk_bf16(float lo, float hi) { unsigned r; asm volatile("v_cvt_pk_bf16_f32 %0, %1, %2" : "=v"(r) : "v"(lo), "v"(hi)); return r; }
typedef float f32x2 __attribute__((ext_vector_type(2)));
__device__ __forceinline__ f32x2 gelu_pk(f32x2 v) {
    const f32x2 av = __builtin_elementwise_abs(v), d = av * 0.2316418882f + 1.0f;
    f32x2 t; t.x = __builtin_amdgcn_rcpf(d.x); t.y = __builtin_amdgcn_rcpf(d.y);
    f32x2 q = t * 0.5307027145f + (-0.7265760135f); q = q * t + 0.7107068705f; q = q * t + (-0.142248368f); q = q * t + 0.127414796f; q = q * t;
    const f32x2 s = (v * v) * (-0.72134752044f);
    f32x2 e; e.x = __builtin_amdgcn_exp2f(s.x); e.y = __builtin_amdgcn_exp2f(s.y);
    const f32x2 m = v * (q * e), r = v - m;
    f32x2 o; o.x = v.x < 0.f ? m.x : r.x; o.y = v.y < 0.f ? m.y : r.y; return o;
}

template <int ACT  > struct EpiBf16 {
    static constexpr bool PERM = true, AFTER_DRAIN = false; static_assert(ACT == 0 || ACT == 1, "EpiBf16: ACT is 0 (none) or 1 (gelu_pk)");
    bf16_t* O; int ldc; const float* bias; int split_cols; size_t split_stride; float scale0;
    __device__ __forceinline__ void operator()(const f32x4 (&acc)[2][2][4][2], const Unit& u, int wr, int wc, int fr, int fq) const {
        const int row0 = u.pm * BM + wr * 64 + fr; int colt = u.pn * BM; bf16_t* base = O;
        float sc = 1.f; if (split_cols) { const int t = colt / split_cols; base += (size_t)t * split_stride; colt -= t * split_cols; if (t == 0) sc = scale0; }
        const int col0 = colt + wc * 32 + 8 * fq, bcol0 = u.pn * BM + wc * 32 + 8 * fq;
        f32x4 bv[2][2];
#pragma unroll
        for (int bj = 0; bj < 2; ++bj)
#pragma unroll
            for (int n = 0; n < 2; ++n) bv[bj][n] = bias ? *(const f32x4*)(bias + bcol0 + bj * HALF + 4 * n) : (f32x4){0.f, 0.f, 0.f, 0.f};
#pragma unroll
        for (int ai = 0; ai < 2; ++ai)
#pragma unroll
            for (int m = 0; m < 4; ++m) { bf16_t* rowp = base + (size_t)(row0 + ai * HALF + m * 16) * ldc + col0;
#pragma unroll
                for (int bj = 0; bj < 2; ++bj) { f32x4 v0 = acc[ai][bj][m][0] + bv[bj][0], v1 = acc[ai][bj][m][1] + bv[bj][1];
                    if (ACT == 1) { f32x2 a = gelu_pk((f32x2){v0[0], v0[1]}), b = gelu_pk((f32x2){v0[2], v0[3]}), c = gelu_pk((f32x2){v1[0], v1[1]}), d = gelu_pk((f32x2){v1[2], v1[3]});
                        v0 = (f32x4){a.x, a.y, b.x, b.y}; v1 = (f32x4){c.x, c.y, d.x, d.y}; }
                    v0 = v0 * sc; v1 = v1 * sc; u32x4 w; w.x = cvt_pk_bf16(v0[0], v0[1]); w.y = cvt_pk_bf16(v0[2], v0[3]); w.z = cvt_pk_bf16(v1[0], v1[1]); w.w = cvt_pk_bf16(v1[2], v1[3]);
                    *(u32x4*)(rowp + bj * HALF) = w; } }
    }
};
template <class Epi, class Sched, bool ALIGN_EPI = false, bool SP2 = false>
__device__ __forceinline__ void gemm_phase(PG8_LAS unsigned char* lds, const Gemm g, const Sched& S, const Epi& E) {
    int tid_l = threadIdx.x; asm volatile("" : "+v"(tid_l));
    const int tid = tid_l, wid = __builtin_amdgcn_readfirstlane(tid >> 6), lane = tid & 63, wr = wid >> 2, wc = wid & 3, fr = lane & 15, fq = lane >> 4;
    const int K = g.K, nt = K / BK;
    unsigned voffA[2], voffB[2];
#pragma unroll
    for (int i = 0; i < 2; ++i) { int R, C; stage_rc(tid * 16 + i * 8192, R, C); const int Rb = Epi::PERM ? ((R & ~31) + perm32(R & 31)) : R;
        voffA[i] = (unsigned)(R * K + C) * 2u; voffB[i] = (unsigned)(Rb * K + C) * 2u; }
    const size_t kstep = (size_t)(BK * 2);
    const size_t hstep = (size_t)HALF * K * 2;
    const size_t tstep = 2 * hstep;
    const unsigned ldsw = (unsigned)wid * 1024u;
    const int aoff = lds_byte(wr * 64 + fr, fq * 8), boff = lds_byte(wc * 32 + fr, fq * 8);
#define PG8_SA(b, h) (((b) * 2 + (h)) * HTB)
#define PG8_SB(b, h) ((4 + (b) * 2 + (h)) * HTB)
#define PG8_STAGE(bufoff, gbase, voff) do { _Pragma("unroll") for (int _i = 0; _i < 2; ++_i) \
        __builtin_amdgcn_global_load_lds((const unsigned*)((const char*)(gbase) + (voff)[_i]), (PG8_LAS unsigned*)(lds + (bufoff) + ldsw + _i * 8192), 16, 0, 0); } while (0)
#define PG8_LDA(dst, b, h) do { _Pragma("unroll") for (int m = 0; m < 4; ++m) _Pragma("unroll") for (int k = 0; k < 2; ++k) dst[m][k] = *(const PG8_LAS bf16x8*)(lds + PG8_SA(b, h) + aoff + m * 2048 + k * 1024); } while (0)
#define PG8_LDB(dst, b, h) do { _Pragma("unroll") for (int n = 0; n < 2; ++n) _Pragma("unroll") for (int k = 0; k < 2; ++k) dst[n][k] = *(const PG8_LAS bf16x8*)(lds + PG8_SB(b, h) + boff + n * 2048 + k * 1024); } while (0)
#define PG8_MMA(ai, bj, At, Bt) do { __builtin_amdgcn_s_setprio(1); _Pragma("unroll") for (int m = 0; m < 4; ++m) _Pragma("unroll") for (int n = 0; n < 2; ++n) _Pragma("unroll") for (int k = 0; k < 2; ++k) \
        acc[ai][bj][m][n] = __builtin_amdgcn_mfma_f32_16x16x32_bf16(Bt[n][k], At[m][k], acc[ai][bj][m][n], 0, 0, 0); __builtin_amdgcn_s_setprio(0); } while (0)
#define PG8_WAIT_V(n) asm volatile("s_waitcnt vmcnt(" #n ")" ::: "memory")
#define PG8_WAIT_L(n) asm volatile("s_waitcnt lgkmcnt(" #n ")" ::: "memory")
#define PG8_BAR __builtin_amdgcn_s_barrier()
#define PG8_SCHED __builtin_amdgcn_sched_barrier(0)
    Unit cur, nxt; int ui = 0;
    if (!S.next(0, cur)) return;
    f32x4 acc[2][2][4][2];
#pragma unroll
    for (int a = 0; a < 2; ++a)
#pragma unroll
        for (int b = 0; b < 2; ++b)
#pragma unroll
            for (int m = 0; m < 4; ++m)
#pragma unroll
                for (int n = 0; n < 2; ++n) acc[a][b][m][n] = (f32x4){0.f, 0.f, 0.f, 0.f};
    bf16x8 At[4][2], B0[2][2], B1[2][2];
    const char* cA = (const char*)g.A + (size_t)cur.pm * tstep; const char* cB = (const char*)g.Bt + (size_t)cur.pn * tstep;
    S.a_ready(cur);
    if constexpr (SP2) {
        PG8_STAGE(PG8_SB(0, 0), cB, voffB); PG8_STAGE(PG8_SB(0, 1), cB + hstep, voffB); PG8_STAGE(PG8_SA(0, 0), cA, voffA); PG8_STAGE(PG8_SA(0, 1), cA + hstep, voffA);
        if (wr == 1) PG8_BAR;
        PG8_WAIT_V(2); PG8_BAR;
        PG8_STAGE(PG8_SB(1, 0), cB + kstep, voffB); PG8_STAGE(PG8_SA(1, 0), cA + kstep, voffA); PG8_STAGE(PG8_SB(1, 1), cB + hstep + kstep, voffB);
        PG8_WAIT_V(6); PG8_BAR;
    } else {
        PG8_STAGE(PG8_SB(0, 0), cB, voffB); PG8_STAGE(PG8_SA(0, 0), cA, voffA); PG8_STAGE(PG8_SB(0, 1), cB + hstep, voffB); PG8_STAGE(PG8_SA(0, 1), cA + hstep, voffA);
        if (wr == 1) PG8_BAR;
        PG8_WAIT_V(4); PG8_BAR;
        PG8_STAGE(PG8_SB(1, 0), cB + kstep, voffB); PG8_STAGE(PG8_SA(1, 0), cA + kstep, voffA); PG8_STAGE(PG8_SB(1, 1), cB + hstep + kstep, voffB);
        PG8_WAIT_V(6); PG8_BAR;
    }
    for (;;) {
        const bool has_next = S.next(ui + 1, nxt);
        const char* nA = has_next ? (const char*)g.A + (size_t)nxt.pm * tstep : cA; const char* nB = has_next ? (const char*)g.Bt + (size_t)nxt.pn * tstep : cB;
        for (int t = 0; t < nt; t += 2) {
            const bool last = (t == nt - 2);
            const char* a1 = cA + (size_t)(t + 1) * kstep;
            const char* a2 = last ? nA : cA + (size_t)(t + 2) * kstep; const char* b2 = last ? nB : cB + (size_t)(t + 2) * kstep;
            const char* a3 = a2 + kstep; const char* b3 = b2 + kstep;
            if (last && has_next) S.a_ready(nxt);
            if constexpr (SP2) {
            PG8_LDB(B0, 0, 0); PG8_LDB(B1, 0, 1); PG8_SCHED; PG8_LDA(At, 0, 0); PG8_STAGE(PG8_SA(1, 1), a1 + hstep, voffA);
            PG8_WAIT_V(8); PG8_WAIT_L(0); PG8_BAR; PG8_MMA(0, 0, At, B0); PG8_MMA(0, 1, At, B1); PG8_BAR; PG8_SCHED;
            PG8_LDA(At, 0, 1); PG8_STAGE(PG8_SB(0, 0), b2, voffB); PG8_STAGE(PG8_SB(0, 1), b2 + hstep, voffB); PG8_STAGE(PG8_SA(0, 0), a2, voffA);
            PG8_WAIT_V(8); PG8_WAIT_L(0); PG8_BAR; PG8_MMA(1, 0, At, B0); PG8_MMA(1, 1, At, B1); PG8_BAR; PG8_SCHED;
            PG8_LDB(B0, 1, 0); PG8_LDB(B1, 1, 1); PG8_SCHED; PG8_LDA(At, 1, 0); PG8_STAGE(PG8_SA(0, 1), a2 + hstep, voffA);
            PG8_WAIT_V(8); PG8_WAIT_L(0); PG8_BAR; PG8_MMA(0, 0, At, B0); PG8_MMA(0, 1, At, B1); PG8_BAR; PG8_SCHED;
            PG8_LDA(At, 1, 1); PG8_STAGE(PG8_SB(1, 0), b3, voffB); PG8_STAGE(PG8_SB(1, 1), b3 + hstep, voffB); PG8_STAGE(PG8_SA(1, 0), a3, voffA);
            PG8_WAIT_V(8); PG8_WAIT_L(0); PG8_BAR; PG8_MMA(1, 0, At, B0); PG8_MMA(1, 1, At, B1); PG8_BAR; PG8_SCHED;
            } else {
            PG8_LDB(B0, 0, 0); PG8_SCHED; PG8_LDA(At, 0, 0); PG8_STAGE(PG8_SA(1, 1), a1 + hstep, voffA);
            PG8_WAIT_L(8); PG8_BAR; PG8_WAIT_L(0); PG8_MMA(0, 0, At, B0); PG8_BAR; PG8_SCHED;
            PG8_LDB(B1, 0, 1); PG8_STAGE(PG8_SB(0, 0), b2, voffB);
            PG8_BAR; PG8_WAIT_L(0); PG8_MMA(0, 1, At, B1); PG8_BAR;
            PG8_LDA(At, 0, 1); PG8_STAGE(PG8_SA(0, 0), a2, voffA);
            PG8_BAR; PG8_WAIT_L(0); PG8_MMA(1, 0, At, B0); PG8_BAR; PG8_SCHED;
            PG8_STAGE(PG8_SB(0, 1), b2 + hstep, voffB);
            PG8_WAIT_V(6); PG8_BAR; PG8_MMA(1, 1, At, B1); PG8_BAR;
            PG8_LDB(B0, 1, 0); PG8_SCHED; PG8_LDA(At, 1, 0); PG8_STAGE(PG8_SA(0, 1), a2 + hstep, voffA);
            PG8_WAIT_L(8); PG8_BAR; PG8_WAIT_L(0); PG8_MMA(0, 0, At, B0); PG8_BAR; PG8_SCHED;
            PG8_LDB(B1, 1, 1); PG8_STAGE(PG8_SB(1, 0), b3, voffB);
            PG8_BAR; PG8_WAIT_L(0); PG8_MMA(0, 1, At, B1); PG8_BAR;
            PG8_LDA(At, 1, 1); PG8_STAGE(PG8_SA(1, 0), a3, voffA);
            PG8_BAR; PG8_WAIT_L(0); PG8_MMA(1, 0, At, B0); PG8_BAR; PG8_SCHED;
            PG8_STAGE(PG8_SB(1, 1), b3 + hstep, voffB);
            PG8_WAIT_V(6); PG8_BAR; PG8_MMA(1, 1, At, B1); PG8_BAR;
            }
        }
        if constexpr (ALIGN_EPI) { if (wr == 0) PG8_BAR; }
        if constexpr (!Epi::AFTER_DRAIN) { E(acc, cur, wr, wc, fr, fq); S.done(cur); }
        if (!has_next) break;
#pragma unroll
        for (int a = 0; a < 2; ++a)
#pragma unroll
            for (int b = 0; b < 2; ++b)
#pragma unroll
                for (int m = 0; m < 4; ++m)
#pragma unroll
                    for (int n = 0; n < 2; ++n) acc[a][b][m][n] = (f32x4){0.f, 0.f, 0.f, 0.f};
        cur = nxt; cA = nA; cB = nB; ++ui;
        if constexpr (ALIGN_EPI) { if (wr == 1) PG8_BAR; }
    }
    PG8_WAIT_V(0);
    if constexpr (!ALIGN_EPI) { if (wr == 0) PG8_BAR; }
    PG8_BAR;
    if constexpr (Epi::AFTER_DRAIN) { E.fused(acc, cur, wr, wc, fr, fq, lds, wid, lane); S.done(cur); }
#undef PG8_SA
#undef PG8_SB
#undef PG8_STAGE
#undef PG8_LDA
#undef PG8_LDB
#undef PG8_MMA
#undef PG8_WAIT_V
#undef PG8_WAIT_L
#undef PG8_BAR
#undef PG8_SCHED
}
}
#define GAS __attribute__((address_space(1)))
#define LAS __attribute__((address_space(3)))
typedef unsigned short bf16;
typedef unsigned v4u __attribute__((ext_vector_type(4)));
typedef float f32x4 __attribute__((ext_vector_type(4)));
typedef short bf16x8 __attribute__((ext_vector_type(8)));
typedef GAS unsigned gu32;
typedef GAS unsigned long long gu64;
#define RLX_AGENT __ATOMIC_RELAXED, __HIP_MEMORY_SCOPE_AGENT
#define LDS_WAIT() asm volatile("s_waitcnt lgkmcnt(0)" ::: "memory")
#define VM_WAIT() asm volatile("s_waitcnt vmcnt(0)" ::: "memory")
__device__ __forceinline__ unsigned long long rt() { return __builtin_amdgcn_s_memrealtime(); }
__device__ __forceinline__ unsigned f2bf(float f) { unsigned u = __builtin_bit_cast(unsigned, f); return (u + 0x7fffu + ((u >> 16) & 1u)) >> 16; }
__device__ __forceinline__ unsigned pk2(float lo, float hi) { return f2bf(lo) | (f2bf(hi) << 16); }
#define XB_TMO      128
#define XB_XCNT(j)  (256  + 64 * (j))
#define XB_XSUB(j)  (1280 + 64 * (j))
#define XB_XGEN(j)  (2304 + 64 * (j))
#define XB_TOP      3328
#define XB_TOPGEN   3392
#define XCD_BAR_WORDS 3456
#define XB_SPIN_CAP (1u << 18)

__device__ __forceinline__ unsigned xb_ld(unsigned* p)              { return __hip_atomic_load(p, __ATOMIC_RELAXED, __HIP_MEMORY_SCOPE_AGENT); }
__device__ __forceinline__ unsigned xb_add(unsigned* p, unsigned v) { return __hip_atomic_fetch_add(p, v, __ATOMIC_RELAXED, __HIP_MEMORY_SCOPE_AGENT); }
__device__ __forceinline__ unsigned xb_xcc_id() { return (unsigned)__builtin_amdgcn_s_getreg((3 << 11) | 20) & 0xFu; }
#define XB_SPIN(cond, bar) do { unsigned _sp = 0; while (cond) { __builtin_amdgcn_s_sleep(1); \
    if ((++_sp & 255u) == 0u) { if (xb_ld(&(bar)[XB_TMO])) break; if (_sp > XB_SPIN_CAP) { atomicAdd(&(bar)[XB_TMO], 1u); break; } } } } while (0)

struct XcdBarrier {
    unsigned* bar; unsigned x;
    volatile LAS unsigned* st;
};

__device__ __forceinline__ XcdBarrier xcd_barrier_post(unsigned* bar, volatile LAS unsigned* st) {
    XcdBarrier b; b.bar = bar; b.x = xb_xcc_id(); b.st = st;
    if (threadIdx.x == 0) (void)xb_add(&bar[XB_XCNT(b.x)], 1u);
    return b;
}
__device__ __forceinline__ void xcd_barrier_complete(unsigned* bar, unsigned x, unsigned& nloc, unsigned& nx) {
    const unsigned G = gridDim.x * gridDim.y * gridDim.z;
    unsigned sum, cnt, mine, sp = 0u;
    for (;;) {
        sum = 0u; cnt = 0u; mine = 0u;
#pragma unroll
        for (unsigned j = 0; j < 16; ++j) { const unsigned c = xb_ld(&bar[XB_XCNT(j)]); sum += c; cnt += (c > 0u) ? 1u : 0u; mine = (j == x) ? c : mine; }
        if (sum == G) break;
        __builtin_amdgcn_s_sleep(1);
        if ((++sp & 255u) == 0u) { if (xb_ld(&bar[XB_TMO])) break; if (sp > XB_SPIN_CAP) { atomicAdd(&bar[XB_TMO], 1u); break; } }
    }
    nloc = mine > 0u ? mine : 1u; nx = cnt > 0u ? cnt : 1u;
}

__device__ __forceinline__ void xcd_barrier(const XcdBarrier& b) {
    asm volatile("s_waitcnt vmcnt(0)" ::: "memory");
    __syncthreads();
    if (threadIdx.x == 0) {
        unsigned* bar = b.bar;
        __builtin_amdgcn_s_waitcnt(0);
        unsigned nloc = b.st[0], nx = b.st[1];
        if (nloc == 0u) { xcd_barrier_complete(bar, b.x, nloc, nx); b.st[0] = nloc; b.st[1] = nx; }
        const unsigned old = xb_add(&bar[XB_XSUB(b.x)], 1u);
        const unsigned gen = old / nloc;
        if (old + 1u == (gen + 1u) * nloc) {
            __builtin_amdgcn_fence(__ATOMIC_RELEASE, "agent");
            asm volatile("s_waitcnt vmcnt(0)" ::: "memory");
            const unsigned og = xb_add(&bar[XB_TOP], 1u);
            const unsigned tg = og / nx;
            if (og + 1u == (tg + 1u) * nx) xb_add(&bar[XB_TOPGEN], 1u);
            else XB_SPIN(xb_ld(&bar[XB_TOPGEN]) == tg, bar);
            __builtin_amdgcn_fence(__ATOMIC_ACQUIRE, "agent");
            xb_add(&bar[XB_XGEN(b.x)], 1u);
            asm volatile("s_waitcnt vmcnt(0)" ::: "memory");
        } else {
            XB_SPIN(xb_ld(&bar[XB_XGEN(b.x)]) == gen, bar);
            __builtin_amdgcn_fence(__ATOMIC_ACQUIRE, "agent");
            asm volatile("s_waitcnt vmcnt(0)" ::: "memory");
        }
    }
    __syncthreads();
}

constexpr int NWAVES = 8;
constexpr int BATCH = 8, SEQ = 2048, D = 1024, M = BATCH * SEQ, NPROJ = 3072, NQP = 2048, NEXP = 16384;
constexpr float LN_EPS = 1e-5f, LOG2E = 1.4426950408889634f, ALPHA = 1.4142135623730951f;
#ifndef MK_N_LAUNCHES
#define MK_N_LAUNCHES 1
#endif
constexpr int NPH = 13;
constexpr int N_LAUNCHES = MK_N_LAUNCHES;

constexpr size_t MiB = 1u << 20;
constexpr size_t WS_CTL = 0, CTL_ZERO_BYTES = 1 * MiB;
constexpr size_t WS_WIN = 2 * MiB;
constexpr size_t WS_WOUT = 14 * MiB;
constexpr size_t WS_WQ = 18 * MiB;
constexpr size_t WS_KEYS = 26 * MiB;
constexpr size_t WS_U = 28 * MiB;
constexpr size_t WS_V = 92 * MiB;
constexpr size_t WS_XB = 156 * MiB;
constexpr size_t WS_PROJ = 188 * MiB;
constexpr size_t WS_H = 188 * MiB;
constexpr size_t WS_QP = 220 * MiB;
constexpr size_t WS_ATT = 284 * MiB;
constexpr size_t WS_X1F = 316 * MiB;
constexpr size_t WS_X1B = 380 * MiB;
constexpr size_t WS_END = 412 * MiB;
constexpr int CW_BAR = 4096;

constexpr int RING_BYTES = 131072, LDSCTL_OFF = RING_BYTES, MISC_OFF = LDSCTL_OFF + 320, LDS_BYTES = 147456;

__device__ __forceinline__ float bf2f(unsigned u16) { return __uint_as_float(u16 << 16); }
__device__ __forceinline__ float wave_sum(float v) {
#pragma unroll
    for (int o = 1; o < 64; o <<= 1) v += __shfl_xor(v, o);
    return v;
}

__device__ __forceinline__ void p0_transpose_item(const float* W, int K, int N, bf16* WT, LAS float* scr, int item, int lane) {
    const int nblk = N / 32, kb = item / nblk, nb = item % nblk, k0 = 64 * kb, n0 = 32 * nb;
#pragma unroll 8
    for (int i = 0; i < 32; ++i) { const int kk = 2 * i + (lane >> 5); scr[kk * 33 + (lane & 31)] = W[(size_t)(k0 + kk) * N + n0 + (lane & 31)]; }
    LDS_WAIT(); asm volatile("" ::: "memory");
    const int c = lane & 7;
#pragma unroll
    for (int j = 0; j < 4; ++j) { const int n = (lane >> 3) + 8 * j; const LAS float* s = scr + (8 * c) * 33 + n;
        v4u o; o.x = pk2(s[0 * 33], s[1 * 33]); o.y = pk2(s[2 * 33], s[3 * 33]); o.z = pk2(s[4 * 33], s[5 * 33]); o.w = pk2(s[6 * 33], s[7 * 33]);
        *(GAS v4u*)(WT + (size_t)(n0 + n) * K + k0 + 8 * c) = o; }
    LDS_WAIT(); asm volatile("" ::: "memory");
}
__device__ __forceinline__ void cvt_stream(const float* src, bf16* dst, size_t n8, size_t gt, size_t ngt) {
    for (size_t c = gt; c < n8; c += ngt) {
        const f32x4 a = *(const GAS f32x4*)(src + c * 8), b = *(const GAS f32x4*)(src + c * 8 + 4);
        v4u o; o.x = pk2(a.x, a.y); o.y = pk2(a.z, a.w); o.z = pk2(b.x, b.y); o.w = pk2(b.z, b.w);
        *(GAS v4u*)(dst + c * 8) = o;
    }
}
__device__ __forceinline__ void ln1_row(const float* xrow, const bf16* hrow, const float* g, const float* bt, float* of, bf16* ob, int lane) {
    f32x4 v[4]; float s = 0.f;
#pragma unroll
    for (int j = 0; j < 4; ++j) {
        const f32x4 xv = ((const GAS f32x4*)xrow)[lane + 64 * j];
        const unsigned long long hw = ((const GAS unsigned long long*)hrow)[lane + 64 * j];
        const unsigned lo = (unsigned)hw, hi = (unsigned)(hw >> 32);
        v[j].x = xv.x * ALPHA + bf2f(lo & 0xffffu); v[j].y = xv.y * ALPHA + bf2f(lo >> 16);
        v[j].z = xv.z * ALPHA + bf2f(hi & 0xffffu); v[j].w = xv.w * ALPHA + bf2f(hi >> 16);
        s += (v[j].x + v[j].y) + (v[j].z + v[j].w);
    }
    const float mean = wave_sum(s) * (1.f / D); float s2 = 0.f;
#pragma unroll
    for (int j = 0; j < 4; ++j) { v[j] = v[j] - mean; s2 += (v[j].x * v[j].x + v[j].y * v[j].y) + (v[j].z * v[j].z + v[j].w * v[j].w); }
    const float rstd = 1.f / sqrtf(wave_sum(s2) * (1.f / D) + LN_EPS);
#pragma unroll
    for (int j = 0; j < 4; ++j) {
        const f32x4 gv = ((const GAS f32x4*)g)[lane + 64 * j], bv = ((const GAS f32x4*)bt)[lane + 64 * j];
        const f32x4 o = v[j] * rstd * gv + bv;
        ((GAS f32x4*)of)[lane + 64 * j] = o;
        ((GAS unsigned long long*)ob)[lane + 64 * j] = (unsigned long long)pk2(o.x, o.y) | ((unsigned long long)pk2(o.z, o.w) << 32);
    }
}

namespace att {
typedef short bf16x8 __attribute__((ext_vector_type(8)));
typedef short s16x4 __attribute__((ext_vector_type(4)));
typedef short v4i16_t __attribute__((ext_vector_type(4)));
typedef float f32x16 __attribute__((ext_vector_type(16)));
typedef unsigned u32x4 __attribute__((ext_vector_type(4)));
typedef float f32x2_t __attribute__((ext_vector_type(2)));
typedef __bf16 bf16x2_t __attribute__((ext_vector_type(2)));
constexpr int LDS_K = 0, LDS_V = 32768, LDS_WS = 65536, LDS_OST = 67584, LDS_T5 = 100352, LDS_RPB = 101632, LDS_ATT_END = LDS_RPB + 3720 * 4;
static_assert(LDS_ATT_END <= RING_BYTES, "attention LDS map");
__device__ __forceinline__ int crow(int r, int hi) { return (r & 3) + 8 * (r >> 2) + 4 * hi; }
__device__ __forceinline__ unsigned cvtpk(float lo, float hi) { f32x2_t v = {lo, hi}; bf16x2_t b = __builtin_convertvector(v, bf16x2_t); return __builtin_bit_cast(unsigned, b); }
__device__ __forceinline__ bf16x8 pack8(const f32x16& P, int B) {
    u32x4 w; w.x = cvtpk(P[B], P[B + 1]); w.y = cvtpk(P[B + 2], P[B + 3]); w.z = cvtpk(P[B + 4], P[B + 5]); w.w = cvtpk(P[B + 6], P[B + 7]);
    return __builtin_bit_cast(bf16x8, w);
}
__device__ __forceinline__ float half_max(float v) { auto rr = __builtin_amdgcn_permlane32_swap(__float_as_uint(v), __float_as_uint(v), false, false); return fmaxf(__uint_as_float(rr[0]), __uint_as_float(rr[1])); }
__device__ __forceinline__ float half_sum(float v) { auto rr = __builtin_amdgcn_permlane32_swap(__float_as_uint(v), __float_as_uint(v), false, false); return __uint_as_float(rr[0]) + __uint_as_float(rr[1]); }
__device__ __forceinline__ s16x4 vtr(LAS const char* p) { return __builtin_bit_cast(s16x4, __builtin_amdgcn_ds_read_tr16_b64_v4i16((LAS v4i16_t*)p)); }
__device__ __forceinline__ bf16x8 vfrag(LAS const char* vp, int off) { const s16x4 lo = vtr(vp + off), hi = vtr(vp + off + 512); return (bf16x8){lo[0], lo[1], lo[2], lo[3], hi[0], hi[1], hi[2], hi[3]}; }

__device__ __forceinline__ void sm_update(f32x16& p0, f32x16& p1, float& m, float& l, f32x16& o0, f32x16& o1, LAS float* wsf, int r32, int hi, bf16x8 (&pa)[4]) {
    float mx = p0[0];
#pragma unroll
    for (int r = 1; r < 16; ++r) mx = fmaxf(mx, p0[r]);
#pragma unroll
    for (int r = 0; r < 16; ++r) mx = fmaxf(mx, p1[r]);
    mx = half_max(mx);
    const float mn = fmaxf(m, mx);
    const float al = __builtin_amdgcn_exp2f(m - mn);
    m = mn;
    float s = 0.f;
#pragma unroll
    for (int r = 0; r < 16; ++r) { p0[r] = __builtin_amdgcn_exp2f(p0[r] - mn); s += p0[r]; }
#pragma unroll
    for (int r = 0; r < 16; ++r) { p1[r] = __builtin_amdgcn_exp2f(p1[r] - mn); s += p1[r]; }
    l = l * al + s;
    if (hi == 0) wsf[r32] = al;
    asm volatile("s_waitcnt lgkmcnt(0)" ::: "memory");
#pragma unroll
    for (int r = 0; r < 16; ++r) { const float f = wsf[crow(r, hi)]; o0[r] *= f; o1[r] *= f; }
    asm volatile("s_waitcnt lgkmcnt(0)" ::: "memory");
    pa[0] = pack8(p0, 0); pa[1] = pack8(p0, 8); pa[2] = pack8(p1, 0); pa[3] = pack8(p1, 8);
}
__device__ __forceinline__ int t5_bucket_idx(int rel) {
    const int n = rel < 0 ? -rel : rel; const int base = rel > 0 ? 16 : 0;
    int v;
    if (n < 8) v = n; else if (n < 12) v = 8; else if (n < 16) v = 9; else if (n < 23) v = 10; else if (n < 32) v = 11; else if (n < 46) v = 12; else if (n < 64) v = 13; else if (n < 91) v = 14; else v = 15;
    return base + v;
}

__device__ __forceinline__ void diff_unit(const bf16* PROJ, bf16* ATT, int b, int h, int qb, LAS char* lds, const float* t5_bias, float lam, float outscale, const float* norm_g) {
    int tid_l = threadIdx.x; asm volatile("" : "+v"(tid_l)); const int tid = tid_l, lane = tid & 63, r32 = lane & 31, hi = lane >> 5; const int wid = __builtin_amdgcn_readfirstlane(tid >> 6);
    LAS char* Kl = lds + LDS_K; LAS char* Vl = lds + LDS_V;
    LAS float* wsf = (LAS float*)(lds + LDS_WS) + wid * 64;
    LAS float* t5 = (LAS float*)(lds + LDS_T5);
    if (tid < 257) t5[tid] = t5_bias[t5_bucket_idx(tid - 128) * 8 + h] * LOG2E;
    const size_t rowbase = (size_t)b * SEQ;
    const int qw = qb * 256 + wid * 32;
    const bf16* Qp = PROJ + (rowbase + qw + r32) * NPROJ + h * 64 + hi * 8;
    bf16x8 qr[4];
#pragma unroll
    for (int d0 = 0; d0 < 4; ++d0) qr[d0] = *(const GAS bf16x8*)(Qp + d0 * 16);
    const bf16* ksrc = PROJ + (rowbase + (tid & 63)) * NPROJ + 512 + h * 64 + (tid >> 6) * 8;
    const bf16* vsrc = PROJ + (rowbase + 16 * (wid & 3) + (lane >> 2)) * NPROJ + 1024 + h * 64 + (wid >> 2) * 32 + (lane & 3) * 8;
    float m0 = -1e30f, m1 = -1e30f, l0 = 0.f, l1 = 0.f;
    f32x16 oa0 = {}, oa1 = {}, ob0 = {}, ob1 = {};
    const float c = 0.17677669529663687f * LOG2E;
    LAS const char* kb = Kl + hi * 1024 + r32 * 16;
    LAS const char* vp0 = Vl + ((lane >> 4) & 1) * 32 + (lane & 3) * 8 + (4 * hi + ((lane & 15) >> 2)) * 64;
#pragma unroll 1
    for (int t = 0; t < SEQ / 64; ++t) {
        const u32x4 kreg = *(const GAS u32x4*)(ksrc + (size_t)t * 64 * NPROJ);
        const u32x4 vreg = *(const GAS u32x4*)(vsrc + (size_t)t * 64 * NPROJ);
        __syncthreads();
        *(LAS u32x4*)(Kl + tid * 16) = kreg; *(LAS u32x4*)(Vl + tid * 16) = vreg;
        __syncthreads();
        const int kv0 = t * 64;
        const int rel_lo = kv0 - (qw + 31), rel_hi = kv0 + 63 - qw;
        const bool far = (rel_hi <= -91 || rel_lo >= 91);
        const float bc = far ? ((rel_lo >= 91) ? t5[256] : t5[0]) : 0.f;
        const int relb = kv0 + 4 * hi - (qw + r32);
#define DIFF_MAP(DB, MM, LL, O0, O1) do { \
        __builtin_amdgcn_sched_barrier(0); \
        f32x16 s0 = {}, s1 = {}; \
        _Pragma("unroll") for (int d0 = (DB); d0 < (DB) + 2; ++d0) { \
            const bf16x8 a0 = *(LAS const bf16x8*)(kb + d0 * 2048), a1 = *(LAS const bf16x8*)(kb + d0 * 2048 + 512); \
            s0 = __builtin_amdgcn_mfma_f32_32x32x16_bf16(a0, qr[d0], s0, 0, 0, 0); s1 = __builtin_amdgcn_mfma_f32_32x32x16_bf16(a1, qr[d0], s1, 0, 0, 0); } \
        if (far) { _Pragma("unroll") for (int r = 0; r < 16; ++r) { s0[r] = s0[r] * c + bc; s1[r] = s1[r] * c + bc; } } \
        else { int relo = relb; asm volatile("" : "+v"(relo)); _Pragma("unroll") for (int r = 0; r < 16; ++r) { const int rel = relo + (r & 3) + 8 * (r >> 2); \
                const int i0 = min(max(rel, -128), 128) + 128, i1 = min(max(rel + 32, -128), 128) + 128; \
                s0[r] = s0[r] * c + t5[i0]; s1[r] = s1[r] * c + t5[i1]; } } \
        bf16x8 pa[4]; \
        sm_update(s0, s1, MM, LL, O0, O1, wsf, r32, hi, pa); \
        __builtin_amdgcn_sched_barrier(0); \
        _Pragma("unroll") for (int ks = 0; ks < 4; ++ks) { \
            const bf16x8 v0 = vfrag(vp0, ks * 1024), v1 = vfrag(vp0, 4096 + ks * 1024); \
            O0 = __builtin_amdgcn_mfma_f32_32x32x16_bf16(pa[ks], v0, O0, 0, 0, 0); O1 = __builtin_amdgcn_mfma_f32_32x32x16_bf16(pa[ks], v1, O1, 0, 0, 0); } \
        } while (0)
        DIFF_MAP(0, m0, l0, oa0, oa1);
        DIFF_MAP(2, m1, l1, ob0, ob1);
#undef DIFF_MAP
    }
    l0 = half_sum(l0); l1 = half_sum(l1);
    if (hi == 0) { wsf[r32] = 1.f / l0; wsf[32 + r32] = lam / l1; }
    asm volatile("s_waitcnt lgkmcnt(0)" ::: "memory");
    const float g0 = norm_g[r32] * outscale, g1 = norm_g[32 + r32] * outscale;
    LAS unsigned short* stg = (LAS unsigned short*)(lds + LDS_OST) + wid * 2048;
#pragma unroll
    for (int r = 0; r < 16; ++r) {
        const int orow = crow(r, hi);
        const float f0 = wsf[orow], f1 = wsf[32 + orow];
        float v0 = oa0[r] * f0 - ob0[r] * f1, v1 = oa1[r] * f0 - ob1[r] * f1;
        float ss = v0 * v0 + v1 * v1;
#pragma unroll
        for (int o = 1; o < 32; o <<= 1) ss += __shfl_xor(ss, o);
        const float sc = 1.f / sqrtf(ss * (1.f / 64.f) + LN_EPS);
        stg[orow * 64 + r32] = (unsigned short)f2bf(v0 * sc * g0); stg[orow * 64 + 32 + r32] = (unsigned short)f2bf(v1 * sc * g1);
    }
    asm volatile("s_waitcnt lgkmcnt(0)" ::: "memory");
    bf16* Ow = ATT + (rowbase + qw) * D + h * 64;
#pragma unroll
    for (int i = 0; i < 4; ++i) { const int row = i * 8 + (lane >> 3), ch = lane & 7; const u32x4 v = *(LAS const u32x4*)(stg + row * 64 + ch * 8); *(GAS u32x4*)(Ow + (size_t)row * D + ch * 8) = v; }
    __syncthreads();
}

__device__ __forceinline__ void na_unit(const bf16* PROJ, bf16* ATT, int b, int hg, int gr, LAS char* lds) {
    int tid_l = threadIdx.x; asm volatile("" : "+v"(tid_l)); const int tid = tid_l, lane = tid & 63, r32 = lane & 31, hi = lane >> 5; const int wid = __builtin_amdgcn_readfirstlane(tid >> 6);
    const int hl = wid >> 1, qh = wid & 1, hh = hg * 4 + hl;
    LAS char* Kl = lds + LDS_K; LAS char* Vl = lds + LDS_V;
    LAS float* wsf = (LAS float*)(lds + LDS_WS) + wid * 64;
    LAS const float* rpb = (LAS const float*)(lds + LDS_RPB) + hh * 465;
    const size_t rowbase = (size_t)b * SEQ;
    const int cq = qh * 32 + r32;
    const bf16* Qp = PROJ + (rowbase + gr * 64 + cq) * NPROJ + 1536 + hh * 64 + hi * 8;
    bf16x8 qr[4];
#pragma unroll
    for (int d0 = 0; d0 < 4; ++d0) qr[d0] = *(const GAS bf16x8*)(Qp + d0 * 16);
    const int rs = min(max(gr - 4, 0), 24);
    const int cs = min(max(cq - 8, 0), 48);
    const bf16* ksrc = PROJ + (rowbase + (tid & 63)) * NPROJ + 2048 + hg * 256 + (tid >> 6) * 8;
    const bf16* vsrc = PROJ + (rowbase + 16 * (wid & 3) + (lane >> 2)) * NPROJ + 2560 + hg * 256 + (wid >> 2) * 32 + (lane & 3) * 8;
    float m = -1e30f, l = 0.f; f32x16 o0 = {}, o1 = {};
    const float sc = 0.125f * LOG2E;
    LAS const char* kb = Kl + hl * 8192 + hi * 1024 + r32 * 16;
    LAS const char* vp0 = Vl + hl * 8192 + ((lane >> 4) & 1) * 32 + (lane & 3) * 8 + (4 * hi + ((lane & 15) >> 2)) * 64;
#pragma unroll 1
    for (int i = 0; i < 8; ++i) {
        const int krow = rs + i;
        u32x4 kreg[4], vreg[4];
#pragma unroll
        for (int j = 0; j < 4; ++j) { kreg[j] = *(const GAS u32x4*)(ksrc + (size_t)krow * 64 * NPROJ + j * 64); vreg[j] = *(const GAS u32x4*)(vsrc + (size_t)krow * 64 * NPROJ + j * 64); }
        __syncthreads();
#pragma unroll
        for (int j = 0; j < 4; ++j) { *(LAS u32x4*)(Kl + j * 8192 + tid * 16) = kreg[j]; *(LAS u32x4*)(Vl + j * 8192 + tid * 16) = vreg[j]; }
        __syncthreads();
        f32x16 p0 = {}, p1 = {};
#pragma unroll
        for (int d0 = 0; d0 < 4; ++d0) {
            const bf16x8 a0 = *(LAS const bf16x8*)(kb + d0 * 2048), a1 = *(LAS const bf16x8*)(kb + d0 * 2048 + 512);
            p0 = __builtin_amdgcn_mfma_f32_32x32x16_bf16(a0, qr[d0], p0, 0, 0, 0); p1 = __builtin_amdgcn_mfma_f32_32x32x16_bf16(a1, qr[d0], p1, 0, 0, 0);
        }
        LAS const float* rp = rpb + (krow - gr + 7) * 31;
#pragma unroll
        for (int r = 0; r < 16; ++r) {
            const int ck0 = crow(r, hi), ck1 = ck0 + 32;
            const bool in0 = (ck0 >= cs) && (ck0 < cs + 16), in1 = (ck1 >= cs) && (ck1 < cs + 16);
            const float b0 = rp[in0 ? ck0 - cq + 15 : 0], b1 = rp[in1 ? ck1 - cq + 15 : 0];
            p0[r] = in0 ? p0[r] * sc + b0 : -1e30f; p1[r] = in1 ? p1[r] * sc + b1 : -1e30f;
        }
        bf16x8 pa[4];
        sm_update(p0, p1, m, l, o0, o1, wsf, r32, hi, pa);
#pragma unroll
        for (int ks = 0; ks < 4; ++ks) {
            const bf16x8 v0 = vfrag(vp0, ks * 1024), v1 = vfrag(vp0, 4096 + ks * 1024);
            o0 = __builtin_amdgcn_mfma_f32_32x32x16_bf16(pa[ks], v0, o0, 0, 0, 0); o1 = __builtin_amdgcn_mfma_f32_32x32x16_bf16(pa[ks], v1, o1, 0, 0, 0);
        }
    }
    l = half_sum(l);
    if (hi == 0) wsf[r32] = 1.f / l;
    asm volatile("s_waitcnt lgkmcnt(0)" ::: "memory");
    LAS unsigned short* stg = (LAS unsigned short*)(lds + LDS_OST) + wid * 2048;
#pragma unroll
    for (int r = 0; r < 16; ++r) { const int orow = crow(r, hi); const float f = wsf[orow]; stg[orow * 64 + r32] = (unsigned short)f2bf(o0[r] * f); stg[orow * 64 + 32 + r32] = (unsigned short)f2bf(o1[r] * f); }
    asm volatile("s_waitcnt lgkmcnt(0)" ::: "memory");
    bf16* Ow = ATT + (rowbase + gr * 64 + qh * 32) * D + 512 + hh * 64;
#pragma unroll
    for (int i = 0; i < 4; ++i) { const int row = i * 8 + (lane >> 3), ch = lane & 7; const u32x4 v = *(LAS const u32x4*)(stg + row * 64 + ch * 8); *(GAS u32x4*)(Ow + (size_t)row * D + ch * 8) = v; }
    __syncthreads();
}
}

namespace peer {
using att::bf16x8; using att::f32x16; using att::u32x4; using att::crow;
constexpr int LDS_KEYS = 0, LDS_IDX = 65536, LDS_G = 81920, LDS_PEER_END = 98304;
static_assert(LDS_PEER_END <= RING_BYTES, "peer LDS map");
__device__ __forceinline__ unsigned ford(float f) { const unsigned u = __float_as_uint(f); return u ^ (((unsigned)((int)u >> 31)) | 0x80000000u); }
__device__ __forceinline__ float fdec(unsigned k) { const unsigned u = (k & 0x80000000u) ? (k ^ 0x80000000u) : ~k; return __uint_as_float(u); }
template <int N> __device__ __forceinline__ void top16(const unsigned (&key)[N], unsigned (&a)[16]) {
    unsigned prev = 0xFFFFFFFFu;
#pragma unroll
    for (int i = 0; i < 16; ++i) a[i] = 0u;
#pragma unroll 1
    for (int p = 0; p < 16; ++p) {
        unsigned best = 0u;
#pragma unroll
        for (int i = 0; i < N; ++i) { const unsigned d = key[i] - prev; best = best > d ? best : d; }
        prev += best;
#pragma unroll
        for (int i = 0; i < 15; ++i) a[i] = a[i + 1];
        a[15] = prev;
    }
}
__device__ __forceinline__ void merge_halves(unsigned (&a)[16]) {
    unsigned c[16];
#pragma unroll
    for (int i = 0; i < 16; ++i) { const unsigned o = (unsigned)__shfl_xor((int)a[15 - i], 32); c[i] = a[i] > o ? a[i] : o; }
#pragma unroll
    for (int d = 8; d >= 1; d >>= 1)
#pragma unroll
        for (int i = 0; i < 16; ++i) if ((i & d) == 0) { const unsigned x = c[i], y = c[i + d]; c[i] = x > y ? x : y; c[i + d] = x > y ? y : x; }
#pragma unroll
    for (int i = 0; i < 16; ++i) a[i] = c[i];
}
__device__ __forceinline__ float gelu_erf(float v) { return 0.5f * v * (1.f + erff(v * 0.70710678118654752f)); }

__device__ __forceinline__ void peer_unit(const bf16* QP, const float* X1F, const bf16* U, const bf16* V, const float* g2, const float* b2, float* outf, bf16* outb, int t0, LAS char* lds) {
    int tid_l = threadIdx.x; asm volatile("" : "+v"(tid_l)); const int tid = tid_l, lane = tid & 63, r32 = lane & 31, hi = lane >> 5; const int wid = __builtin_amdgcn_readfirstlane(tid >> 6);
    LAS const char* keysL = lds + LDS_KEYS; LAS int* idxL = (LAS int*)(lds + LDS_IDX); LAS float* gL = (LAS float*)(lds + LDS_G);
    unsigned A[16], B[16];
#pragma unroll 1
    for (int half = 0; half < 2; ++half) {
        const bf16* qp = QP + (size_t)(t0 + r32) * NQP + wid * 256 + half * 128 + hi * 8;
        bf16x8 qf[8];
#pragma unroll
        for (int d0 = 0; d0 < 8; ++d0) qf[d0] = *(const GAS bf16x8*)(qp + d0 * 16);
        f32x16 acc[4] = {};
        LAS const char* kp = keysL + half * 32768 + hi * 2048 + r32 * 16;
#pragma unroll
        for (int kt = 0; kt < 4; ++kt)
#pragma unroll
            for (int d0 = 0; d0 < 8; ++d0) { const bf16x8 a = *(LAS const bf16x8*)(kp + d0 * 4096 + kt * 512); acc[kt] = __builtin_amdgcn_mfma_f32_32x32x16_bf16(a, qf[d0], acc[kt], 0, 0, 0); }
        unsigned key[64];
#pragma unroll
        for (int kt = 0; kt < 4; ++kt)
#pragma unroll
            for (int r = 0; r < 16; ++r) key[kt * 16 + r] = (ford(acc[kt][r]) & ~127u) | (unsigned)(127 - (kt * 32 + (r & 3) + 8 * (r >> 2)) - 4 * hi);
        unsigned a[16];
        top16<64>(key, a);
        merge_halves(a);
#pragma unroll
        for (int i = 0; i < 16; ++i) { if (half == 0) A[i] = a[i]; else B[i] = a[i]; }
    }
    {
        float fa[16], fb[16];
#pragma unroll
        for (int i = 0; i < 16; ++i) { fa[i] = fdec(A[i]); fb[i] = fdec(B[i]); }
        unsigned ck[50]; int n = 0;
#pragma unroll
        for (int i = 0; i < 16; ++i)
#pragma unroll
            for (int j = 0; j < 16; ++j) if ((i + 1) * (j + 1) <= 16) { ck[n] = (ford(fa[i] + fb[j]) & ~255u) | (unsigned)(255 - (i * 16 + j)); ++n; }
        unsigned w[16];
        top16<50>(ck, w);
        const unsigned thr = w[15]; const float smax = fdec(w[0]);
        float sum = 0.f; n = 0;
#pragma unroll
        for (int i = 0; i < 16; ++i)
#pragma unroll
            for (int j = 0; j < 16; ++j) if ((i + 1) * (j + 1) <= 16) { const float e = (ck[n] >= thr) ? __builtin_amdgcn_exp2f((fa[i] + fb[j] - smax) * LOG2E) : 0.f; sum += e; ++n; }
        const float inv = 1.f / sum;
        int pos = 0; n = 0;
        LAS int* io = idxL + r32 * 128 + wid * 16; LAS float* go = gL + r32 * 128 + wid * 16;
#pragma unroll
        for (int i = 0; i < 16; ++i)
#pragma unroll
            for (int j = 0; j < 16; ++j) if ((i + 1) * (j + 1) <= 16) {
                if (ck[n] >= thr && hi == 0) { io[pos] = (127 - (int)(A[i] & 127u)) * 128 + (127 - (int)(B[j] & 127u)); go[pos] = __builtin_amdgcn_exp2f((fa[i] + fb[j] - smax) * LOG2E) * inv; }
                pos += (ck[n] >= thr) ? 1 : 0; ++n; }
    }
    __syncthreads();
#pragma unroll 1
    for (int tt = 0; tt < 4; ++tt) {
        const int tl = wid * 4 + tt; const size_t tok = (size_t)(t0 + tl);
        float xv[16];
#pragma unroll
        for (int jj = 0; jj < 2; ++jj) { const f32x4 a = *(const GAS f32x4*)(X1F + tok * D + lane * 8 + 512 * jj), b = *(const GAS f32x4*)(X1F + tok * D + lane * 8 + 512 * jj + 4);
            xv[jj * 8 + 0] = a.x; xv[jj * 8 + 1] = a.y; xv[jj * 8 + 2] = a.z; xv[jj * 8 + 3] = a.w; xv[jj * 8 + 4] = b.x; xv[jj * 8 + 5] = b.y; xv[jj * 8 + 6] = b.z; xv[jj * 8 + 7] = b.w; }
        int idxv[2]; float wv[2];
#pragma unroll
        for (int hf = 0; hf < 2; ++hf) {
            idxv[hf] = idxL[tl * 128 + hf * 64 + lane]; const float gv = gL[tl * 128 + hf * 64 + lane];
            float hsel = 0.f;
#pragma unroll 1
            for (int sb = 0; sb < 64; sb += 8) {
                u32x4 ur[8][2];
#pragma unroll
                for (int k = 0; k < 8; ++k) { const int e = __builtin_amdgcn_readlane(idxv[hf], sb + k); const bf16* up = U + (size_t)e * D + lane * 8;
                    ur[k][0] = *(const GAS u32x4*)up; ur[k][1] = *(const GAS u32x4*)(up + 512); }
#pragma unroll
                for (int k = 0; k < 8; ++k) { float d = 0.f;
#pragma unroll
                    for (int jj = 0; jj < 2; ++jj)
#pragma unroll
                        for (int q = 0; q < 4; ++q) { const unsigned w = ur[k][jj][q]; d += bf2f(w & 0xffffu) * xv[jj * 8 + 2 * q] + __uint_as_float(w & 0xffff0000u) * xv[jj * 8 + 2 * q + 1]; }
                    d = wave_sum(d);
                    hsel = (lane == sb + k) ? d : hsel; }
            }
            wv[hf] = gv * gelu_erf(hsel);
        }
        float acc[16];
#pragma unroll
        for (int e = 0; e < 16; ++e) acc[e] = 0.f;
#pragma unroll
        for (int hf = 0; hf < 2; ++hf) {
#pragma unroll 1
            for (int sb = 0; sb < 64; sb += 8) {
                u32x4 vr[8][2];
#pragma unroll
                for (int k = 0; k < 8; ++k) { const int e = __builtin_amdgcn_readlane(idxv[hf], sb + k); const bf16* vp = V + (size_t)e * D + lane * 8;
                    vr[k][0] = *(const GAS u32x4*)vp; vr[k][1] = *(const GAS u32x4*)(vp + 512); }
#pragma unroll
                for (int k = 0; k < 8; ++k) { const float ws = __uint_as_float((unsigned)__builtin_amdgcn_readlane((int)__float_as_uint(wv[hf]), sb + k));
#pragma unroll
                    for (int jj = 0; jj < 2; ++jj)
#pragma unroll
                        for (int q = 0; q < 4; ++q) { const unsigned w = vr[k][jj][q]; acc[jj * 8 + 2 * q] += ws * bf2f(w & 0xffffu); acc[jj * 8 + 2 * q + 1] += ws * __uint_as_float(w & 0xffff0000u); } }
            }
        }
        float s = 0.f;
#pragma unroll
        for (int e = 0; e < 16; ++e) { acc[e] += ALPHA * xv[e]; s += acc[e]; }
        const float mean = wave_sum(s) * (1.f / D); float s2 = 0.f;
#pragma unroll
        for (int e = 0; e < 16; ++e) { acc[e] -= mean; s2 += acc[e] * acc[e]; }
        const float rstd = 1.f / sqrtf(wave_sum(s2) * (1.f / D) + LN_EPS);
#pragma unroll
        for (int jj = 0; jj < 2; ++jj) {
            const size_t co = (size_t)lane * 8 + 512 * jj;
            const f32x4 ga = *(const GAS f32x4*)(g2 + co), gb = *(const GAS f32x4*)(g2 + co + 4), ba = *(const GAS f32x4*)(b2 + co), bb = *(const GAS f32x4*)(b2 + co + 4);
            f32x4 oa, ob;
            oa.x = acc[jj * 8 + 0] * rstd * ga.x + ba.x; oa.y = acc[jj * 8 + 1] * rstd * ga.y + ba.y; oa.z = acc[jj * 8 + 2] * rstd * ga.z + ba.z; oa.w = acc[jj * 8 + 3] * rstd * ga.w + ba.w;
            ob.x = acc[jj * 8 + 4] * rstd * gb.x + bb.x; ob.y = acc[jj * 8 + 5] * rstd * gb.y + bb.y; ob.z = acc[jj * 8 + 6] * rstd * gb.z + bb.z; ob.w = acc[jj * 8 + 7] * rstd * gb.w + bb.w;
            *(GAS f32x4*)(outf + tok * D + co) = oa; *(GAS f32x4*)(outf + tok * D + co + 4) = ob;
            v4u pk; pk.x = pk2(oa.x, oa.y); pk.y = pk2(oa.z, oa.w); pk.z = pk2(ob.x, ob.y); pk.w = pk2(ob.z, ob.w);
            *(GAS v4u*)(outb + tok * D + co) = pk;
        }
    }
    __syncthreads();
}
}

struct Args { const float* in[18]; float* out; unsigned char* ws; int ph_lo, ph_hi; };
__global__ void __launch_bounds__(NWAVES * 64, 2) fwd_kernel(Args args) {
    extern __shared__ __attribute__((aligned(16))) unsigned char lds_raw[];
    LAS unsigned char* lds = (LAS unsigned char*)lds_raw;
    volatile LAS unsigned* MISC = (volatile LAS unsigned*)(lds + MISC_OFF);
    const int tid0 = threadIdx.x; const int wave = __builtin_amdgcn_readfirstlane(tid0 >> 6);
#define PHASE_TID() int tid = threadIdx.x; asm volatile("" : "+v"(tid)); const int lane = tid & 63; (void)lane
    const int G = gridDim.x; const int bx = blockIdx.x; const int vcu = (G % 8 == 0) ? (bx % 8) * (G / 8) + bx / 8 : bx;
    unsigned char* ws = args.ws;
    gu32* ctl = (gu32*)(ws + WS_CTL);
    for (int u = tid0; u < (LDS_BYTES - LDSCTL_OFF) / 4; u += NWAVES * 64) ((LAS unsigned*)(lds + LDSCTL_OFF))[u] = 0u;
    __syncthreads();
    XcdBarrier bar; bar.bar = (unsigned*)(ctl + CW_BAR); bar.x = 0; bar.st = nullptr;
    if (N_LAUNCHES == 1) bar = xcd_barrier_post((unsigned*)(ctl + CW_BAR), MISC + 8);
    const int lo = args.ph_lo, hi = args.ph_hi;
#ifndef PHMASK
#define PHMASK 0x37f
#endif
#define EN(j) ((PHMASK >> (j)) & 1)
#define IN(k) (lo <= (k) && (k) < hi)
#define BOTH(k) (IN(k) && IN((k) + 1))
#define GRID_BAR() do { if (N_LAUNCHES == 1) xcd_barrier(bar); } while (0)
    const float* x_in = args.in[0];
    bf16* WIN = (bf16*)(ws + WS_WIN); bf16* WOUT = (bf16*)(ws + WS_WOUT); bf16* WQ = (bf16*)(ws + WS_WQ); bf16* KEYSB = (bf16*)(ws + WS_KEYS);
    bf16* UB = (bf16*)(ws + WS_U); bf16* VB = (bf16*)(ws + WS_V); bf16* XB = (bf16*)(ws + WS_XB); bf16* PROJ = (bf16*)(ws + WS_PROJ); bf16* HB = (bf16*)(ws + WS_H);
    bf16* QP = (bf16*)(ws + WS_QP); bf16* ATT = (bf16*)(ws + WS_ATT); float* X1F = (float*)(ws + WS_X1F); bf16* X1B = (bf16*)(ws + WS_X1B);
    const int gw = vcu * NWAVES + wave, NGW = G * NWAVES;

    if (EN(0) && IN(0)) {
        PHASE_TID();
        LAS float* scr = (LAS float*)(lds + wave * 16384);
        constexpr int I_IN = (D / 64) * (NPROJ / 32), I_OUT = (D / 64) * (D / 32), I_Q = (D / 64) * (NQP / 32), I_L = I_IN + I_OUT + I_Q;
        for (int it = gw; it < 2 * I_L; it += NGW) {
            const int l = it / I_L; int r = it % I_L;
            if (r < I_IN) { p0_transpose_item(args.in[1] + (size_t)l * D * NPROJ, D, NPROJ, WIN + (size_t)l * NPROJ * D, scr, r, lane); continue; } r -= I_IN;
            if (r < I_OUT) { p0_transpose_item(args.in[2] + (size_t)l * D * D, D, D, WOUT + (size_t)l * D * D, scr, r, lane); continue; } r -= I_OUT;
            p0_transpose_item(args.in[12] + (size_t)l * D * NQP, D, NQP, WQ + (size_t)l * NQP * D, scr, r, lane);
        }
        const size_t gt = (size_t)vcu * (NWAVES * 64) + tid, ngt = (size_t)G * NWAVES * 64;
        cvt_stream(args.in[14], UB, (size_t)2 * NEXP * D / 8, gt, ngt);
        cvt_stream(args.in[15], VB, (size_t)2 * NEXP * D / 8, gt, ngt);
        cvt_stream(x_in, XB, (size_t)M * D / 8, gt, ngt);
        cvt_stream(args.in[13], KEYSB, (size_t)2 * 2 * 128 * 128 / 8, gt, ngt);
        if (BOTH(0)) GRID_BAR();
    }

#pragma unroll 1
    for (int l = 0; l < 2; ++l) {
        const int pb = 1 + 6 * l;
        const float* xres = (l == 0) ? x_in : args.out;
        if (EN(1) && IN(pb)) {
            pg8::Gemm g{XB, WIN + (size_t)l * NPROJ * D, M, NPROJ, D}; pg8::StaticOrder S; S.init(M, NPROJ, G, bx);
            pg8::EpiBf16<0> E{PROJ, NPROJ, nullptr, 0, 0, 1.f};
            pg8::gemm_phase<pg8::EpiBf16<0>, pg8::StaticOrder, true, true>(lds, g, S, E);
            if (BOTH(pb)) GRID_BAR();
        }
        if (EN(2) && IN(pb + 1)) {
            PHASE_TID();
            float s1 = 0.f, s2 = 0.f;
            for (int i = 0; i < 32; ++i) { s1 += args.in[3][l * 32 + i] * args.in[4][l * 32 + i]; s2 += args.in[5][l * 32 + i] * args.in[6][l * 32 + i]; }
            const float lam_init = 0.8f - 0.6f * expf(-0.3f * (float)l);
            const float lam = expf(s1) - expf(s2) + lam_init;
            { LAS float* rp = (LAS float*)(lds + att::LDS_RPB); const float* src = args.in[9] + (size_t)l * 3720; for (int i = tid; i < 3720; i += NWAVES * 64) rp[i] = src[i] * LOG2E; }
            __syncthreads();
            if (EN(8)) for (int i = 0; i < 2; ++i) { const int u = vcu * 2 + i; if (u < 512) att::diff_unit(PROJ, ATT, (u >> 3) >> 3, (u >> 3) & 7, u & 7, (LAS char*)lds, args.in[8], lam, 1.f - lam_init, args.in[7] + l * 64); }
            if (EN(9)) for (int i = 0; i < 2; ++i) { const int u = vcu * 2 + i; if (u < 512) att::na_unit(PROJ, ATT, u >> 6, (u >> 5) & 1, u & 31, (LAS char*)lds); }
            if (BOTH(pb + 1)) GRID_BAR();
        }
        if (EN(3) && IN(pb + 2)) {
            pg8::Gemm g{ATT, WOUT + (size_t)l * D * D, M, D, D}; pg8::StaticOrder S; S.init(M, D, G, bx);
            pg8::EpiBf16<0> E{HB, D, nullptr, 0, 0, 1.f};
            pg8::gemm_phase<pg8::EpiBf16<0>, pg8::StaticOrder, true, true>(lds, g, S, E);
            if (BOTH(pb + 2)) GRID_BAR();
        }
        if (EN(4) && IN(pb + 3)) {
            PHASE_TID();
            for (int m = gw; m < M; m += NGW) ln1_row(xres + (size_t)m * D, HB + (size_t)m * D, args.in[10] + l * D, args.in[11] + l * D, X1F + (size_t)m * D, X1B + (size_t)m * D, lane);
            if (BOTH(pb + 3)) GRID_BAR();
        }
        if (EN(5) && IN(pb + 4)) {
            pg8::Gemm g{X1B, WQ + (size_t)l * NQP * D, M, NQP, D}; pg8::StaticOrder S; S.init(M, NQP, G, bx);
            pg8::EpiBf16<0> E{QP, NQP, nullptr, 0, 0, 1.f};
            pg8::gemm_phase<pg8::EpiBf16<0>, pg8::StaticOrder, true, true>(lds, g, S, E);
            if (BOTH(pb + 4)) GRID_BAR();
        }
        if (EN(6) && IN(pb + 5)) {
            PHASE_TID();
            { const bf16* ks = KEYSB + (size_t)l * 2 * 128 * 128;
              for (int p = tid; p < 4096; p += NWAVES * 64) { const int half = p >> 11, key = (p >> 4) & 127, chunk = p & 15;
                  *(LAS v4u*)(lds + peer::LDS_KEYS + half * 32768 + chunk * 2048 + key * 16) = *(const GAS v4u*)(ks + (size_t)p * 8); } }
            __syncthreads();
            for (int i = 0; i < 2; ++i) { const int u = vcu * 2 + i; if (u < 512) peer::peer_unit(QP, X1F, UB + (size_t)l * NEXP * D, VB + (size_t)l * NEXP * D, args.in[16] + l * D, args.in[17] + l * D, args.out, XB, u * 32, (LAS char*)lds); }
            if (BOTH(pb + 5)) GRID_BAR();
        }
    }
#undef IN
#undef BOTH
#undef GRID_BAR
}

extern "C" void kernel_launch(void* const* d_in, const int* in_sizes, int n_in, void* d_out, int out_size, void* d_ws, size_t ws_size, hipStream_t stream) {
    static int grid = 0;
    if (grid == 0) {
        if (n_in != 18 || in_sizes[0] != M * D || out_size != M * D || ws_size < WS_END) { fprintf(stderr, "kernel_launch: unexpected shapes (n_in %d, in0 %d, out %d, ws %zu); nothing launched\n", n_in, n_in > 0 ? in_sizes[0] : -1, out_size, ws_size); grid = -1; return; }
        int dev = 0, cus = 0, per_cu = 0;
        if (hipGetDevice(&dev) != hipSuccess || hipDeviceGetAttribute(&cus, hipDeviceAttributeMultiprocessorCount, dev) != hipSuccess) { grid = -1; return; }
        if (hipFuncSetAttribute((const void*)fwd_kernel, hipFuncAttributeMaxDynamicSharedMemorySize, LDS_BYTES) != hipSuccess) { fprintf(stderr, "kernel_launch: hipFuncSetAttribute failed\n"); grid = -1; return; }
        if (hipOccupancyMaxActiveBlocksPerMultiprocessor(&per_cu, (const void*)fwd_kernel, NWAVES * 64, LDS_BYTES) != hipSuccess || per_cu < 1) fprintf(stderr, "kernel_launch: occupancy query reports %d workgroups per CU\n", per_cu);
        (void)hipGetLastError();
        grid = cus;
    }
    if (grid < 0) return;
    if (hipMemsetAsync((char*)d_ws + WS_CTL, 0, CTL_ZERO_BYTES, stream) != hipSuccess) return;
    Args a{};
    for (int i = 0; i < 18; ++i) a.in[i] = (const float*)d_in[i];
    a.out = (float*)d_out; a.ws = (unsigned char*)d_ws;
    if (N_LAUNCHES == 1) { a.ph_lo = 0; a.ph_hi = NPH; hipLaunchKernelGGL(fwd_kernel, dim3(grid), dim3(NWAVES * 64), LDS_BYTES, stream, a); }
    else { for (int p = 0; p < NPH; ++p) { a.ph_lo = p; a.ph_hi = p + 1; hipLaunchKernelGGL(fwd_kernel, dim3(grid), dim3(NWAVES * 64), LDS_BYTES, stream, a); } }
}
```

```cpp
#include <hip/hip_runtime.h>
#include <cstdio>
#include <cstdint>
#include <cmath>
namespace pg8 {
#define PG8_LAS __attribute__((address_space(3)))
typedef unsigned short bf16_t;
typedef short bf16x8 __attribute__((ext_vector_type(8)));
typedef float f32x4 __attribute__((ext_vector_type(4)));
typedef unsigned u32x4 __attribute__((ext_vector_type(4)));
constexpr int BM = 256, BK = 64, HALF = 128, HTB = HALF * BK * 2  , STAGE_BYTES = 8 * HTB, NXCD = 8, WGM = 8;

__host__ __device__ __forceinline__ int lds_byte(int r, int c) { const int st = (r >> 4) * 2 + (c >> 5), rr = r & 15, cc = c & 31, ob = rr * 64 + cc * 2; return st * 1024 + (ob ^ (((ob >> 9) & 1) << 5)); }
__host__ __device__ __forceinline__ void stage_rc(int b, int& R, int& C) { const int st = b / 1024, sb = b % 1024, swz = sb ^ (((sb >> 9) & 1) << 5); R = (st >> 1) * 16 + swz / 64; C = (st & 1) * 32 + (swz % 64) / 2; }
__host__ __device__ __forceinline__ int perm32(int rho) { const int n = rho >> 4, i = rho & 15; return 8 * (i >> 2) + 4 * n + (i & 3); }

struct Unit { int pm, pn; };
struct Gemm { const bf16_t* A; const bf16_t* Bt; int M, N, K; };

struct StaticOrder {
    int nM, nN, nwg, G, c;
    __host__ __device__ void init(int M, int N, int G_, int c_) { nM = M / BM; nN = N / BM; nwg = nM * nN; G = G_; c = c_; }
    __host__ __device__ bool next(int i, Unit& u) const {
        const long L = (long)i * G + c; if (L >= nwg) return false;
        int wgid = (int)L; { const int q = nwg / NXCD, r = nwg % NXCD, xcd = wgid % NXCD, off = wgid / NXCD; wgid = (xcd < r ? xcd * (q + 1) : r * (q + 1) + (xcd - r) * q) + off; }
        const int nig = WGM * nN, gid = wgid / nig, fm = gid * WGM, gsz = (nM - fm) < WGM ? (nM - fm) : WGM;
        u.pm = fm + ((wgid % nig) % gsz); u.pn = (wgid % nig) / gsz; return true;
    }
    __device__ __forceinline__ void a_ready(const Unit&) const {}
    __device__ __forceinline__ void done(const Unit&) const {}
};

__device__ __forceinline__ unsigned cvt_pk_bf16(float lo, float hi) { unsigned r; asm volatile("v_cvt_pk_bf16_f32 %0, %1, %2" : "=v"(r) : "v"(lo), "v"(hi)); return r; }
typedef float f32x2 __attribute__((ext_vector_type(2)));
__device__ __forceinline__ f32x2 gelu_pk(f32x2 v) {
    const f32x2 av = __builtin_elementwise_abs(v), d = av * 0.2316418882f + 1.0f;
    f32x2 t; t.x = __builtin_amdgcn_rcpf(d.x); t.y = __builtin_amdgcn_rcpf(d.y);
    f32x2 q = t * 0.5307027145f + (-0.7265760135f); q = q * t + 0.7107068705f; q = q * t + (-0.142248368f); q = q * t + 0.127414796f; q = q * t;
    const f32x2 s = (v * v) * (-0.72134752044f);
    f32x2 e; e.x = __builtin_amdgcn_exp2f(s.x); e.y = __builtin_amdgcn_exp2f(s.y);
    const f32x2 m = v * (q * e), r = v - m;
    f32x2 o; o.x = v.x < 0.f ? m.x : r.x; o.y = v.y < 0.f ? m.y : r.y; return o;
}

template <int ACT  > struct EpiBf16 {
    static constexpr bool PERM = true, AFTER_DRAIN = false; static_assert(ACT == 0 || ACT == 1, "EpiBf16: ACT is 0 (none) or 1 (gelu_pk)");
    bf16_t* O; int ldc; const float* bias; int split_cols; size_t split_stride; float scale0;
    __device__ __forceinline__ void operator()(const f32x4 (&acc)[2][2][4][2], const Unit& u, int wr, int wc, int fr, int fq) const {
        const int row0 = u.pm * BM + wr * 64 + fr; int colt = u.pn * BM; bf16_t* base = O;
        float sc = 1.f; if (split_cols) { const int t = colt / split_cols; base += (size_t)t * split_stride; colt -= t * split_cols; if (t == 0) sc = scale0; }
        const int col0 = colt + wc * 32 + 8 * fq, bcol0 = u.pn * BM + wc * 32 + 8 * fq;
        f32x4 bv[2][2];
#pragma unroll
        for (int bj = 0; bj < 2; ++bj)
#pragma unroll
            for (int n = 0; n < 2; ++n) bv[bj][n] = bias ? *(const f32x4*)(bias + bcol0 + bj * HALF + 4 * n) : (f32x4){0.f, 0.f, 0.f, 0.f};
#pragma unroll
        for (int ai = 0; ai < 2; ++ai)
#pragma unroll
            for (int m = 0; m < 4; ++m) { bf16_t* rowp = base + (size_t)(row0 + ai * HALF + m * 16) * ldc + col0;
#pragma unroll
                for (int bj = 0; bj < 2; ++bj) { f32x4 v0 = acc[ai][bj][m][0] + bv[bj][0], v1 = acc[ai][bj][m][1] + bv[bj][1];
                    if (ACT == 1) { f32x2 a = gelu_pk((f32x2){v0[0], v0[1]}), b = gelu_pk((f32x2){v0[2], v0[3]}), c = gelu_pk((f32x2){v1[0], v1[1]}), d = gelu_pk((f32x2){v1[2], v1[3]});
                        v0 = (f32x4){a.x, a.y, b.x, b.y}; v1 = (f32x4){c.x, c.y, d.x, d.y}; }
                    v0 = v0 * sc; v1 = v1 * sc; u32x4 w; w.x = cvt_pk_bf16(v0[0], v0[1]); w.y = cvt_pk_bf16(v0[2], v0[3]); w.z = cvt_pk_bf16(v1[0], v1[1]); w.w = cvt_pk_bf16(v1[2], v1[3]);
                    *(u32x4*)(rowp + bj * HALF) = w; } }
    }
};
template <class Epi, class Sched, bool ALIGN_EPI = false, bool SP2 = false>
__device__ __forceinline__ void gemm_phase(PG8_LAS unsigned char* lds, const Gemm g, const Sched& S, const Epi& E) {
    int tid_l = threadIdx.x; asm volatile("" : "+v"(tid_l));
    const int tid = tid_l, wid = __builtin_amdgcn_readfirstlane(tid >> 6), lane = tid & 63, wr = wid >> 2, wc = wid & 3, fr = lane & 15, fq = lane >> 4;
    const int K = g.K, nt = K / BK;
    unsigned voffA[2], voffB[2];
#pragma unroll
    for (int i = 0; i < 2; ++i) { int R, C; stage_rc(tid * 16 + i * 8192, R, C); const int Rb = Epi::PERM ? ((R & ~31) + perm32(R & 31)) : R;
        voffA[i] = (unsigned)(R * K + C) * 2u; voffB[i] = (unsigned)(Rb * K + C) * 2u; }
    const size_t kstep = (size_t)(BK * 2);
    const size_t hstep = (size_t)HALF * K * 2;
    const size_t tstep = 2 * hstep;
    const unsigned ldsw = (unsigned)wid * 1024u;
    const int aoff = lds_byte(wr * 64 + fr, fq * 8), boff = lds_byte(wc * 32 + fr, fq * 8);
#define PG8_SA(b, h) (((b) * 2 + (h)) * HTB)
#define PG8_SB(b, h) ((4 + (b) * 2 + (h)) * HTB)
#define PG8_STAGE(bufoff, gbase, voff) do { _Pragma("unroll") for (int _i = 0; _i < 2; ++_i) \
        __builtin_amdgcn_global_load_lds((const unsigned*)((const char*)(gbase) + (voff)[_i]), (PG8_LAS unsigned*)(lds + (bufoff) + ldsw + _i * 8192), 16, 0, 0); } while (0)
#define PG8_LDA(dst, b, h) do { _Pragma("unroll") for (int m = 0; m < 4; ++m) _Pragma("unroll") for (int k = 0; k < 2; ++k) dst[m][k] = *(const PG8_LAS bf16x8*)(lds + PG8_SA(b, h) + aoff + m * 2048 + k * 1024); } while (0)
#define PG8_LDB(dst, b, h) do { _Pragma("unroll") for (int n = 0; n < 2; ++n) _Pragma("unroll") for (int k = 0; k < 2; ++k) dst[n][k] = *(const PG8_LAS bf16x8*)(lds + PG8_SB(b, h) + boff + n * 2048 + k * 1024); } while (0)
#define PG8_MMA(ai, bj, At, Bt) do { __builtin_amdgcn_s_setprio(1); _Pragma("unroll") for (int m = 0; m < 4; ++m) _Pragma("unroll") for (int n = 0; n < 2; ++n) _Pragma("unroll") for (int k = 0; k < 2; ++k) \
        acc[ai][bj][m][n] = __builtin_amdgcn_mfma_f32_16x16x32_bf16(Bt[n][k], At[m][k], acc[ai][bj][m][n], 0, 0, 0); __builtin_amdgcn_s_setprio(0); } while (0)
#define PG8_WAIT_V(n) asm volatile("s_waitcnt vmcnt(" #n ")" ::: "memory")
#define PG8_WAIT_L(n) asm volatile("s_waitcnt lgkmcnt(" #n ")" ::: "memory")
#define PG8_BAR __builtin_amdgcn_s_barrier()
#define PG8_SCHED __builtin_amdgcn_sched_barrier(0)
    Unit cur, nxt; int ui = 0;
    if (!S.next(0, cur)) return;
    f32x4 acc[2][2][4][2];
#pragma unroll
    for (int a = 0; a < 2; ++a)
#pragma unroll
        for (int b = 0; b < 2; ++b)
#pragma unroll
            for (int m = 0; m < 4; ++m)
#pragma unroll
                for (int n = 0; n < 2; ++n) acc[a][b][m][n] = (f32x4){0.f, 0.f, 0.f, 0.f};
    bf16x8 At[4][2], B0[2][2], B1[2][2];
    const char* cA = (const char*)g.A + (size_t)cur.pm * tstep; const char* cB = (const char*)g.Bt + (size_t)cur.pn * tstep;
    S.a_ready(cur);
    if constexpr (SP2) {
        PG8_STAGE(PG8_SB(0, 0), cB, voffB); PG8_STAGE(PG8_SB(0, 1), cB + hstep, voffB); PG8_STAGE(PG8_SA(0, 0), cA, voffA); PG8_STAGE(PG8_SA(0, 1), cA + hstep, voffA);
        if (wr == 1) PG8_BAR;
        PG8_WAIT_V(2); PG8_BAR;
        PG8_STAGE(PG8_SB(1, 0), cB + kstep, voffB); PG8_STAGE(PG8_SA(1, 0), cA + kstep, voffA); PG8_STAGE(PG8_SB(1, 1), cB + hstep + kstep, voffB);
        PG8_WAIT_V(6); PG8_BAR;
    } else {
        PG8_STAGE(PG8_SB(0, 0), cB, voffB); PG8_STAGE(PG8_SA(0, 0), cA, voffA); PG8_STAGE(PG8_SB(0, 1), cB + hstep, voffB); PG8_STAGE(PG8_SA(0, 1), cA + hstep, voffA);
        if (wr == 1) PG8_BAR;
        PG8_WAIT_V(4); PG8_BAR;
        PG8_STAGE(PG8_SB(1, 0), cB + kstep, voffB); PG8_STAGE(PG8_SA(1, 0), cA + kstep, voffA); PG8_STAGE(PG8_SB(1, 1), cB + hstep + kstep, voffB);
        PG8_WAIT_V(6); PG8_BAR;
    }
    for (;;) {
        const bool has_next = S.next(ui + 1, nxt);
        const char* nA = has_next ? (const char*)g.A + (size_t)nxt.pm * tstep : cA; const char* nB = has_next ? (const char*)g.Bt + (size_t)nxt.pn * tstep : cB;
        for (int t = 0; t < nt; t += 2) {
            const bool last = (t == nt - 2);
            const char* a1 = cA + (size_t)(t + 1) * kstep;
            const char* a2 = last ? nA : cA + (size_t)(t + 2) * kstep; const char* b2 = last ? nB : cB + (size_t)(t + 2) * kstep;
            const char* a3 = a2 + kstep; const char* b3 = b2 + kstep;
            if (last && has_next) S.a_ready(nxt);
            if constexpr (SP2) {
            PG8_LDB(B0, 0, 0); PG8_LDB(B1, 0, 1); PG8_SCHED; PG8_LDA(At, 0, 0); PG8_STAGE(PG8_SA(1, 1), a1 + hstep, voffA);
            PG8_WAIT_V(8); PG8_WAIT_L(0); PG8_BAR; PG8_MMA(0, 0, At, B0); PG8_MMA(0, 1, At, B1); PG8_BAR; PG8_SCHED;
            PG8_LDA(At, 0, 1); PG8_STAGE(PG8_SB(0, 0), b2, voffB); PG8_STAGE(PG8_SB(0, 1), b2 + hstep, voffB); PG8_STAGE(PG8_SA(0, 0), a2, voffA);
            PG8_WAIT_V(8); PG8_WAIT_L(0); PG8_BAR; PG8_MMA(1, 0, At, B0); PG8_MMA(1, 1, At, B1); PG8_BAR; PG8_SCHED;
            PG8_LDB(B0, 1, 0); PG8_LDB(B1, 1, 1); PG8_SCHED; PG8_LDA(At, 1, 0); PG8_STAGE(PG8_SA(0, 1), a2 + hstep, voffA);
            PG8_WAIT_V(8); PG8_WAIT_L(0); PG8_BAR; PG8_MMA(0, 0, At, B0); PG8_MMA(0, 1, At, B1); PG8_BAR; PG8_SCHED;
            PG8_LDA(At, 1, 1); PG8_STAGE(PG8_SB(1, 0), b3, voffB); PG8_STAGE(PG8_SB(1, 1), b3 + hstep, voffB); PG8_STAGE(PG8_SA(1, 0), a3, voffA);
            PG8_WAIT_V(8); PG8_WAIT_L(0); PG8_BAR; PG8_MMA(1, 0, At, B0); PG8_MMA(1, 1, At, B1); PG8_BAR; PG8_SCHED;
            } else {
            PG8_LDB(B0, 0, 0); PG8_SCHED; PG8_LDA(At, 0, 0); PG8_STAGE(PG8_SA(1, 1), a1 + hstep, voffA);
            PG8_WAIT_L(8); PG8_BAR; PG8_WAIT_L(0); PG8_MMA(0, 0, At, B0); PG8_BAR; PG8_SCHED;
            PG8_LDB(B1, 0, 1); PG8_STAGE(PG8_SB(0, 0), b2, voffB);
            PG8_BAR; PG8_WAIT_L(0); PG8_MMA(0, 1, At, B1); PG8_BAR;
            PG8_LDA(At, 0, 1); PG8_STAGE(PG8_SA(0, 0), a2, voffA);
            PG8_BAR; PG8_WAIT_L(0); PG8_MMA(1, 0, At, B0); PG8_BAR; PG8_SCHED;
            PG8_STAGE(PG8_SB(0, 1), b2 + hstep, voffB);
            PG8_WAIT_V(6); PG8_BAR; PG8_MMA(1, 1, At, B1); PG8_BAR;
            PG8_LDB(B0, 1, 0); PG8_SCHED; PG8_LDA(At, 1, 0); PG8_STAGE(PG8_SA(0, 1), a2 + hstep, voffA);
            PG8_WAIT_L(8); PG8_BAR; PG8_WAIT_L(0); PG8_MMA(0, 0, At, B0); PG8_BAR; PG8_SCHED;
            PG8_LDB(B1, 1, 1); PG8_STAGE(PG8_SB(1, 0), b3, voffB);
            PG8_BAR; PG8_WAIT_L(0); PG8_MMA(0, 1, At, B1); PG8_BAR;
            PG8_LDA(At, 1, 1); PG8_STAGE(PG8_SA(1, 0), a3, voffA);
            PG8_BAR; PG8_WAIT_L(0); PG8_MMA(1, 0, At, B0); PG8_BAR; PG8_SCHED;
            PG8_STAGE(PG8_SB(1, 1), b3 + hstep, voffB);
            PG8_WAIT_V(6); PG8_BAR; PG8_MMA(1, 1, At, B1); PG8_BAR;
            }
        }
        if constexpr (ALIGN_EPI) { if (wr == 0) PG8_BAR; }
        if constexpr (!Epi::AFTER_DRAIN) { E(acc, cur, wr, wc, fr, fq); S.done(cur); }
        if (!has_next) break;
#pragma unroll
        for (int a = 0; a < 2; ++a)
#pragma unroll
            for (int b = 0; b < 2; ++b)
#pragma unroll
                for (int m = 0; m < 4; ++m)
#pragma unroll
                    for (int n = 0; n < 2; ++n) acc[a][b][m][n] = (f32x4){0.f, 0.f, 0.f, 0.f};
        cur = nxt; cA = nA; cB = nB; ++ui;
        if constexpr (ALIGN_EPI) { if (wr == 1) PG8_BAR; }
    }
    PG8_WAIT_V(0);
    if constexpr (!ALIGN_EPI) { if (wr == 0) PG8_BAR; }
    PG8_BAR;
    if constexpr (Epi::AFTER_DRAIN) { E.fused(acc, cur, wr, wc, fr, fq, lds, wid, lane); S.done(cur); }
#undef PG8_SA
#undef PG8_SB
#undef PG8_STAGE
#undef PG8_LDA
#undef PG8_LDB
#undef PG8_MMA
#undef PG8_WAIT_V
#undef PG8_WAIT_L
#undef PG8_BAR
#undef PG8_SCHED
}
}
#define GAS __attribute__((address_space(1)))
#define LAS __attribute__((address_space(3)))
typedef unsigned short bf16;
typedef unsigned v4u __attribute__((ext_vector_type(4)));
typedef float f32x4 __attribute__((ext_vector_type(4)));
typedef short bf16x8 __attribute__((ext_vector_type(8)));
typedef GAS unsigned gu32;
typedef GAS unsigned long long gu64;
#define RLX_AGENT __ATOMIC_RELAXED, __HIP_MEMORY_SCOPE_AGENT
#define LDS_WAIT() asm volatile("s_waitcnt lgkmcnt(0)" ::: "memory")
#define VM_WAIT() asm volatile("s_waitcnt vmcnt(0)" ::: "memory")
__device__ __forceinline__ unsigned long long rt() { return __builtin_amdgcn_s_memrealtime(); }
__device__ __forceinline__ unsigned f2bf(float f) { unsigned u = __builtin_bit_cast(unsigned, f); return (u + 0x7fffu + ((u >> 16) & 1u)) >> 16; }
__device__ __forceinline__ unsigned pk2(float lo, float hi) { return f2bf(lo) | (f2bf(hi) << 16); }
#define XB_TMO      128
#define XB_XCNT(j)  (256  + 64 * (j))
#define XB_XSUB(j)  (1280 + 64 * (j))
#define XB_XGEN(j)  (2304 + 64 * (j))
#define XB_TOP      3328
#define XB_TOPGEN   3392
#define XCD_BAR_WORDS 3456
#define XB_SPIN_CAP (1u << 18)

__device__ __forceinline__ unsigned xb_ld(unsigned* p)              { return __hip_atomic_load(p, __ATOMIC_RELAXED, __HIP_MEMORY_SCOPE_AGENT); }
__device__ __forceinline__ unsigned xb_add(unsigned* p, unsigned v) { return __hip_atomic_fetch_add(p, v, __ATOMIC_RELAXED, __HIP_MEMORY_SCOPE_AGENT); }
__device__ __forceinline__ unsigned xb_xcc_id() { return (unsigned)__builtin_amdgcn_s_getreg((3 << 11) | 20) & 0xFu; }
#define XB_SPIN(cond, bar) do { unsigned _sp = 0; while (cond) { __builtin_amdgcn_s_sleep(1); \
    if ((++_sp & 255u) == 0u) { if (xb_ld(&(bar)[XB_TMO])) break; if (_sp > XB_SPIN_CAP) { atomicAdd(&(bar)[XB_TMO], 1u); break; } } } } while (0)

struct XcdBarrier {
    unsigned* bar; unsigned x;
    volatile LAS unsigned* st;
};

__device__ __forceinline__ XcdBarrier xcd_barrier_post(unsigned* bar, volatile LAS unsigned* st) {
    XcdBarrier b; b.bar = bar; b.x = xb_xcc_id(); b.st = st;
    if (threadIdx.x == 0) (void)xb_add(&bar[XB_XCNT(b.x)], 1u);
    return b;
}
__device__ __forceinline__ void xcd_barrier_complete(unsigned* bar, unsigned x, unsigned& nloc, unsigned& nx) {
    const unsigned G = gridDim.x * gridDim.y * gridDim.z;
    unsigned sum, cnt, mine, sp = 0u;
    for (;;) {
        sum = 0u; cnt = 0u; mine = 0u;
#pragma unroll
        for (unsigned j = 0; j < 16; ++j) { const unsigned c = xb_ld(&bar[XB_XCNT(j)]); sum += c; cnt += (c > 0u) ? 1u : 0u; mine = (j == x) ? c : mine; }
        if (sum == G) break;
        __builtin_amdgcn_s_sleep(1);
        if ((++sp & 255u) == 0u) { if (xb_ld(&bar[XB_TMO])) break; if (sp > XB_SPIN_CAP) { atomicAdd(&bar[XB_TMO], 1u); break; } }
    }
    nloc = mine > 0u ? mine : 1u; nx = cnt > 0u ? cnt : 1u;
}

__device__ __forceinline__ void xcd_barrier(const XcdBarrier& b) {
    asm volatile("s_waitcnt vmcnt(0)" ::: "memory");
    __syncthreads();
    if (threadIdx.x == 0) {
        unsigned* bar = b.bar;
        __builtin_amdgcn_s_waitcnt(0);
        unsigned nloc = b.st[0], nx = b.st[1];
        if (nloc == 0u) { xcd_barrier_complete(bar, b.x, nloc, nx); b.st[0] = nloc; b.st[1] = nx; }
        const unsigned old = xb_add(&bar[XB_XSUB(b.x)], 1u);
        const unsigned gen = old / nloc;
        if (old + 1u == (gen + 1u) * nloc) {
            __builtin_amdgcn_fence(__ATOMIC_RELEASE, "agent");
            asm volatile("s_waitcnt vmcnt(0)" ::: "memory");
            const unsigned og = xb_add(&bar[XB_TOP], 1u);
            const unsigned tg = og / nx;
            if (og + 1u == (tg + 1u) * nx) xb_add(&bar[XB_TOPGEN], 1u);
            else XB_SPIN(xb_ld(&bar[XB_TOPGEN]) == tg, bar);
            __builtin_amdgcn_fence(__ATOMIC_ACQUIRE, "agent");
            xb_add(&bar[XB_XGEN(b.x)], 1u);
            asm volatile("s_waitcnt vmcnt(0)" ::: "memory");
        } else {
            XB_SPIN(xb_ld(&bar[XB_XGEN(b.x)]) == gen, bar);
            __builtin_amdgcn_fence(__ATOMIC_ACQUIRE, "agent");
            asm volatile("s_waitcnt vmcnt(0)" ::: "memory");
        }
    }
    __syncthreads();
}

constexpr int NWAVES = 8;
constexpr int BATCH = 8, SEQ = 2048, D = 1024, M = BATCH * SEQ, NPROJ = 3072, NQP = 2048, NEXP = 16384;
constexpr float LN_EPS = 1e-5f, LOG2E = 1.4426950408889634f, ALPHA = 1.4142135623730951f;
#ifndef MK_N_LAUNCHES
#define MK_N_LAUNCHES 1
#endif
constexpr int NPH = 21;
constexpr int N_LAUNCHES = MK_N_LAUNCHES;

constexpr size_t MiB = 1u << 20;
constexpr size_t WS_CTL = 0, CTL_ZERO_BYTES = 1 * MiB;
constexpr size_t WS_WIN = 2 * MiB;
constexpr size_t WS_WOUT = 14 * MiB;
constexpr size_t WS_WQ = 18 * MiB;
constexpr size_t WS_KEYS = 26 * MiB;
constexpr size_t WS_UQ = 28 * MiB;
constexpr size_t WS_VQ = 60 * MiB;
constexpr size_t WS_US = 92 * MiB;
constexpr size_t WS_VS = 92 * MiB + 256 * 1024;
constexpr size_t WS_XQ = 93 * MiB;
constexpr size_t WS_XS = 109 * MiB;
constexpr size_t WS_IDX = 110 * MiB;
constexpr size_t WS_GW = 118 * MiB;
constexpr size_t WS_WV = 446 * MiB;
constexpr size_t WS_XB = 126 * MiB;
constexpr size_t WS_PROJ = 158 * MiB;
constexpr size_t WS_H = 158 * MiB;
constexpr size_t WS_QP = 190 * MiB;
constexpr size_t WS_F = 190 * MiB;
constexpr size_t WS_ATT = 254 * MiB;
constexpr size_t WS_X1F = 286 * MiB;
constexpr size_t WS_X1B = 350 * MiB;
constexpr size_t WS_HP = 382 * MiB;
constexpr size_t WS_END = 454 * MiB;
constexpr int CW_BAR = 4096;

constexpr int RING_BYTES = 131072, LDSCTL_OFF = RING_BYTES, MISC_OFF = LDSCTL_OFF + 320, LDS_BYTES = 147456;

__device__ __forceinline__ float bf2f(unsigned u16) { return __uint_as_float(u16 << 16); }
__device__ __forceinline__ float wave_sum(float v) {
#pragma unroll
    for (int o = 1; o < 64; o <<= 1) v += __shfl_xor(v, o);
    return v;
}

__device__ __forceinline__ void p0_transpose_item(const float* W, int K, int N, bf16* WT, LAS float* scr, int item, int lane) {
    const int nblk = N / 32, kb = item / nblk, nb = item % nblk, k0 = 64 * kb, n0 = 32 * nb;
#pragma unroll 8
    for (int i = 0; i < 32; ++i) { const int kk = 2 * i + (lane >> 5); scr[kk * 33 + (lane & 31)] = W[(size_t)(k0 + kk) * N + n0 + (lane & 31)]; }
    LDS_WAIT(); asm volatile("" ::: "memory");
    const int c = lane & 7;
#pragma unroll
    for (int j = 0; j < 4; ++j) { const int n = (lane >> 3) + 8 * j; const LAS float* s = scr + (8 * c) * 33 + n;
        v4u o; o.x = pk2(s[0 * 33], s[1 * 33]); o.y = pk2(s[2 * 33], s[3 * 33]); o.z = pk2(s[4 * 33], s[5 * 33]); o.w = pk2(s[6 * 33], s[7 * 33]);
        *(GAS v4u*)(WT + (size_t)(n0 + n) * K + k0 + 8 * c) = o; }
    LDS_WAIT(); asm volatile("" ::: "memory");
}
__device__ __forceinline__ void cvt_stream(const float* src, bf16* dst, size_t n8, size_t gt, size_t ngt) {
    for (size_t c = gt; c < n8; c += ngt) {
        const f32x4 a = *(const GAS f32x4*)(src + c * 8), b = *(const GAS f32x4*)(src + c * 8 + 4);
        v4u o; o.x = pk2(a.x, a.y); o.y = pk2(a.z, a.w); o.z = pk2(b.x, b.y); o.w = pk2(b.z, b.w);
        *(GAS v4u*)(dst + c * 8) = o;
    }
}
__device__ __forceinline__ float wave_max(float v) {
#pragma unroll
    for (int o = 1; o < 64; o <<= 1) v = fmaxf(v, __shfl_xor(v, o));
    return v;
}
template <int OFS> __device__ __forceinline__ void quant_row(const float* row, unsigned char* qbase, size_t e, float* scale_out, int lane) {
    f32x4 v[4]; float am = 0.f;
#pragma unroll
    for (int i = 0; i < 4; ++i) { v[i] = ((const GAS f32x4*)row)[lane * 4 + i]; am = fmaxf(am, fmaxf(fmaxf(fabsf(v[i].x), fabsf(v[i].y)), fmaxf(fabsf(v[i].z), fabsf(v[i].w)))); }
    am = wave_max(am);
    const float inv = am > 0.f ? 127.f / am : 0.f;
    v4u o;
#pragma unroll
    for (int i = 0; i < 4; ++i) {
        const int q0 = (int)rintf(v[i].x * inv) + OFS, q1 = (int)rintf(v[i].y * inv) + OFS, q2 = (int)rintf(v[i].z * inv) + OFS, q3 = (int)rintf(v[i].w * inv) + OFS;
        o[i] = (unsigned)(q0 & 0xff) | ((unsigned)(q1 & 0xff) << 8) | ((unsigned)(q2 & 0xff) << 16) | ((unsigned)(q3 & 0xff) << 24);
    }
    *(GAS v4u*)(qbase + ((size_t)(lane >> 3) * NEXP + e) * 128 + (lane & 7) * 16) = o;
    if (lane == 0) *scale_out = am > 0.f ? am * (1.f / 127.f) : 1.f;
}
__device__ __forceinline__ void ln1_row(const float* xrow, const bf16* hrow, const float* g, const float* bt, float* of, bf16* ob, unsigned char* xq, float* xs, size_t m, int lane) {
    f32x4 v[4]; float s = 0.f;
#pragma unroll
    for (int j = 0; j < 4; ++j) {
        const f32x4 xv = ((const GAS f32x4*)xrow)[lane + 64 * j];
        const unsigned long long hw = ((const GAS unsigned long long*)hrow)[lane + 64 * j];
        const unsigned lo = (unsigned)hw, hi = (unsigned)(hw >> 32);
        v[j].x = xv.x * ALPHA + bf2f(lo & 0xffffu); v[j].y = xv.y * ALPHA + bf2f(lo >> 16);
        v[j].z = xv.z * ALPHA + bf2f(hi & 0xffffu); v[j].w = xv.w * ALPHA + bf2f(hi >> 16);
        s += (v[j].x + v[j].y) + (v[j].z + v[j].w);
    }
    const float mean = wave_sum(s) * (1.f / D); float s2 = 0.f;
#pragma unroll
    for (int j = 0; j < 4; ++j) { v[j] = v[j] - mean; s2 += (v[j].x * v[j].x + v[j].y * v[j].y) + (v[j].z * v[j].z + v[j].w * v[j].w); }
    const float rstd = 1.f / sqrtf(wave_sum(s2) * (1.f / D) + LN_EPS);
    float am = 0.f;
#pragma unroll
    for (int j = 0; j < 4; ++j) {
        const f32x4 gv = ((const GAS f32x4*)g)[lane + 64 * j], bv = ((const GAS f32x4*)bt)[lane + 64 * j];
        const f32x4 o = v[j] * rstd * gv + bv; v[j] = o;
        ((GAS f32x4*)of)[lane + 64 * j] = o;
        ((GAS unsigned long long*)ob)[lane + 64 * j] = (unsigned long long)pk2(o.x, o.y) | ((unsigned long long)pk2(o.z, o.w) << 32);
        am = fmaxf(am, fmaxf(fmaxf(fabsf(o.x), fabsf(o.y)), fmaxf(fabsf(o.z), fabsf(o.w))));
    }
    am = wave_max(am);
    const float inv = am > 0.f ? 127.f / am : 0.f;
#pragma unroll
    for (int j = 0; j < 4; ++j) {
        const int q0 = (int)rintf(v[j].x * inv), q1 = (int)rintf(v[j].y * inv), q2 = (int)rintf(v[j].z * inv), q3 = (int)rintf(v[j].w * inv);
        const unsigned w = (unsigned)(q0 & 0xff) | ((unsigned)(q1 & 0xff) << 8) | ((unsigned)(q2 & 0xff) << 16) | ((unsigned)(q3 & 0xff) << 24);
        *(GAS unsigned*)(xq + ((size_t)(2 * j + (lane >> 5)) * M + m) * 128 + 4 * (lane & 31)) = w;
    }
    if (lane == 0) xs[m] = am > 0.f ? am * (1.f / 127.f) : 1.f;
}
__device__ __forceinline__ void ln2_row(const float* xrow, const float* frow, const float* g, const float* bt, float* of, bf16* ob, int lane) {
    f32x4 v[4]; float s = 0.f;
#pragma unroll
    for (int j = 0; j < 4; ++j) {
        const f32x4 xv = ((const GAS f32x4*)xrow)[lane + 64 * j], fv = ((const GAS f32x4*)frow)[lane + 64 * j];
        v[j] = xv * ALPHA + fv;
        s += (v[j].x + v[j].y) + (v[j].z + v[j].w);
    }
    const float mean = wave_sum(s) * (1.f / D); float s2 = 0.f;
#pragma unroll
    for (int j = 0; j < 4; ++j) { v[j] = v[j] - mean; s2 += (v[j].x * v[j].x + v[j].y * v[j].y) + (v[j].z * v[j].z + v[j].w * v[j].w); }
    const float rstd = 1.f / sqrtf(wave_sum(s2) * (1.f / D) + LN_EPS);
#pragma unroll
    for (int j = 0; j < 4; ++j) {
        const f32x4 gv = ((const GAS f32x4*)g)[lane + 64 * j], bv = ((const GAS f32x4*)bt)[lane + 64 * j];
        const f32x4 o = v[j] * rstd * gv + bv;
        ((GAS f32x4*)of)[lane + 64 * j] = o;
        ((GAS unsigned long long*)ob)[lane + 64 * j] = (unsigned long long)pk2(o.x, o.y) | ((unsigned long long)pk2(o.z, o.w) << 32);
    }
}

namespace att {
typedef short bf16x8 __attribute__((ext_vector_type(8)));
typedef short s16x4 __attribute__((ext_vector_type(4)));
typedef short v4i16_t __attribute__((ext_vector_type(4)));
typedef float f32x16 __attribute__((ext_vector_type(16)));
typedef unsigned u32x4 __attribute__((ext_vector_type(4)));
typedef float f32x2_t __attribute__((ext_vector_type(2)));
typedef __bf16 bf16x2_t __attribute__((ext_vector_type(2)));
constexpr int LDS_K = 0, LDS_V = 32768, LDS_WS = 65536, LDS_OST = 67584, LDS_T5 = 100352, LDS_RPB = 101632, LDS_ATT_END = LDS_RPB + 3720 * 4;
static_assert(LDS_ATT_END <= RING_BYTES, "attention LDS map");
__device__ __forceinline__ int crow(int r, int hi) { return (r & 3) + 8 * (r >> 2) + 4 * hi; }
__device__ __forceinline__ unsigned cvtpk(float lo, float hi) { f32x2_t v = {lo, hi}; bf16x2_t b = __builtin_convertvector(v, bf16x2_t); return __builtin_bit_cast(unsigned, b); }
__device__ __forceinline__ bf16x8 pack8(const f32x16& P, int B) {
    u32x4 w; w.x = cvtpk(P[B], P[B + 1]); w.y = cvtpk(P[B + 2], P[B + 3]); w.z = cvtpk(P[B + 4], P[B + 5]); w.w = cvtpk(P[B + 6], P[B + 7]);
    return __builtin_bit_cast(bf16x8, w);
}
__device__ __forceinline__ float half_max(float v) { auto rr = __builtin_amdgcn_permlane32_swap(__float_as_uint(v), __float_as_uint(v), false, false); return fmaxf(__uint_as_float(rr[0]), __uint_as_float(rr[1])); }
__device__ __forceinline__ float half_sum(float v) { auto rr = __builtin_amdgcn_permlane32_swap(__float_as_uint(v), __float_as_uint(v), false, false); return __uint_as_float(rr[0]) + __uint_as_float(rr[1]); }
__device__ __forceinline__ s16x4 vtr(LAS const char* p) { return __builtin_bit_cast(s16x4, __builtin_amdgcn_ds_read_tr16_b64_v4i16((LAS v4i16_t*)p)); }
__device__ __forceinline__ bf16x8 vfrag(LAS const char* vp, int off) { const s16x4 lo = vtr(vp + off), hi = vtr(vp + off + 512); return (bf16x8){lo[0], lo[1], lo[2], lo[3], hi[0], hi[1], hi[2], hi[3]}; }

__device__ __forceinline__ void sm_update(f32x16& p0, f32x16& p1, float c, float off, float& m, float& l, f32x16& o0, f32x16& o1, LAS float* wsf, int r32, int hi, bf16x8 (&pa)[4]) {
    float mx = fmaxf(p0[0], p1[0]);
#pragma unroll
    for (int r = 1; r < 16; ++r) mx = fmaxf(mx, fmaxf(p0[r], p1[r]));
    mx = half_max(mx) * c + off;
    if (__any(mx > m + 8.f)) {
        const float mn = fmaxf(m, mx);
        const float al = __builtin_amdgcn_exp2f(m - mn);
        m = mn; l *= al;
        if (hi == 0) wsf[r32] = al;
        asm volatile("s_waitcnt lgkmcnt(0)" ::: "memory");
#pragma unroll
        for (int r = 0; r < 16; ++r) { const float f = wsf[crow(r, hi)]; o0[r] *= f; o1[r] *= f; }
        asm volatile("s_waitcnt lgkmcnt(0)" ::: "memory");
    }
    const float nb = off - m;
    float s0 = 0.f, s1 = 0.f;
#pragma unroll
    for (int r = 0; r < 16; ++r) { p0[r] = __builtin_amdgcn_exp2f(__builtin_fmaf(p0[r], c, nb)); s0 += p0[r]; p1[r] = __builtin_amdgcn_exp2f(__builtin_fmaf(p1[r], c, nb)); s1 += p1[r]; }
    l += s0 + s1;
    pa[0] = pack8(p0, 0); pa[1] = pack8(p0, 8); pa[2] = pack8(p1, 0); pa[3] = pack8(p1, 8);
}
__device__ __forceinline__ int t5_bucket_idx(int rel) {
    const int n = rel < 0 ? -rel : rel; const int base = rel > 0 ? 16 : 0;
    int v;
    if (n < 8) v = n; else if (n < 12) v = 8; else if (n < 16) v = 9; else if (n < 23) v = 10; else if (n < 32) v = 11; else if (n < 46) v = 12; else if (n < 64) v = 13; else if (n < 91) v = 14; else v = 15;
    return base + v;
}

__device__ __forceinline__ void diff_unit(const bf16* PROJ, bf16* ATT, int b, int h, int qb, LAS char* lds, const float* t5_bias, float lam, float outscale, const float* norm_g) {
    int tid_l = threadIdx.x; asm volatile("" : "+v"(tid_l)); const int tid = tid_l, lane = tid & 63, r32 = lane & 31, hi = lane >> 5; const int wid = __builtin_amdgcn_readfirstlane(tid >> 6);
    LAS char* Kl = lds + LDS_K; LAS char* Vl = lds + LDS_V;
    LAS float* wsf = (LAS float*)(lds + LDS_WS) + wid * 64;
    LAS float* t5 = (LAS float*)(lds + LDS_T5);
    if (tid < 257) t5[tid] = t5_bias[t5_bucket_idx(tid - 128) * 8 + h] * LOG2E;
    const size_t rowbase = (size_t)b * SEQ;
    const int qw = qb * 256 + wid * 32;
    const bf16* Qp = PROJ + (rowbase + qw + r32) * NPROJ + h * 64 + hi * 8;
    bf16x8 qr[4];
#pragma unroll
    for (int d0 = 0; d0 < 4; ++d0) qr[d0] = *(const GAS bf16x8*)(Qp + d0 * 16);
    const bf16* ksrc = PROJ + (rowbase + (tid & 63)) * NPROJ + 512 + h * 64 + (tid >> 6) * 8;
    const bf16* vsrc = PROJ + (rowbase + 16 * (wid & 3) + (lane >> 2)) * NPROJ + 1024 + h * 64 + (wid >> 2) * 32 + (lane & 3) * 8;
    float m0 = -1e30f, m1 = -1e30f, l0 = 0.f, l1 = 0.f;
    f32x16 oa0 = {}, oa1 = {}, ob0 = {}, ob1 = {};
    const float c = 0.17677669529663687f * LOG2E;
    LAS const char* kb = Kl + hi * 1024 + r32 * 16;
    LAS const char* vp0 = Vl + ((lane >> 4) & 1) * 32 + (lane & 3) * 8 + (4 * hi + ((lane & 15) >> 2)) * 64;
    u32x4 kreg = *(const GAS u32x4*)ksrc, vreg = *(const GAS u32x4*)vsrc;
    *(LAS u32x4*)(Kl + tid * 16) = kreg; *(LAS u32x4*)(Vl + tid * 16) = vreg;
    kreg = *(const GAS u32x4*)(ksrc + (size_t)64 * NPROJ); vreg = *(const GAS u32x4*)(vsrc + (size_t)64 * NPROJ);
#pragma unroll 1
    for (int t = 0; t < SEQ / 64; ++t) {
        const int cur = (t & 1) * 8192, nxt = 8192 - cur;
        __syncthreads();
        if (t + 1 < SEQ / 64) { *(LAS u32x4*)(Kl + nxt + tid * 16) = kreg; *(LAS u32x4*)(Vl + nxt + tid * 16) = vreg; }
        { const int t2 = (t + 2 < SEQ / 64) ? t + 2 : t; kreg = *(const GAS u32x4*)(ksrc + (size_t)t2 * 64 * NPROJ); vreg = *(const GAS u32x4*)(vsrc + (size_t)t2 * 64 * NPROJ); }
        const int kv0 = t * 64;
        const int rel_lo = kv0 - (qw + 31), rel_hi = kv0 + 63 - qw;
        const bool far = (rel_hi <= -91 || rel_lo >= 91);
        const float bc = far ? ((rel_lo >= 91) ? t5[256] : t5[0]) : 0.f;
        const int relb = kv0 + 4 * hi - (qw + r32);
#define DIFF_MAP(DB, MM, LL, O0, O1) do { \
        __builtin_amdgcn_sched_barrier(0); \
        f32x16 s0 = {}, s1 = {}; \
        _Pragma("unroll") for (int d0 = (DB); d0 < (DB) + 2; ++d0) { \
            const bf16x8 a0 = *(LAS const bf16x8*)(kb + cur + d0 * 2048), a1 = *(LAS const bf16x8*)(kb + cur + d0 * 2048 + 512); \
            s0 = __builtin_amdgcn_mfma_f32_32x32x16_bf16(a0, qr[d0], s0, 0, 0, 0); s1 = __builtin_amdgcn_mfma_f32_32x32x16_bf16(a1, qr[d0], s1, 0, 0, 0); } \
        bf16x8 pa[4]; \
        if (far) sm_update(s0, s1, c, bc, MM, LL, O0, O1, wsf, r32, hi, pa); \
        else { int relo = relb; asm volatile("" : "+v"(relo)); _Pragma("unroll") for (int r = 0; r < 16; ++r) { const int rel = relo + (r & 3) + 8 * (r >> 2); \
                const int i0 = min(max(rel, -128), 128) + 128, i1 = min(max(rel + 32, -128), 128) + 128; \
                s0[r] = s0[r] * c + t5[i0]; s1[r] = s1[r] * c + t5[i1]; } \
            sm_update(s0, s1, 1.f, 0.f, MM, LL, O0, O1, wsf, r32, hi, pa); } \
        __builtin_amdgcn_sched_barrier(0); \
        _Pragma("unroll") for (int ks = 0; ks < 4; ++ks) { \
            const bf16x8 v0 = vfrag(vp0 + cur, ks * 1024), v1 = vfrag(vp0 + cur, 4096 + ks * 1024); \
            O0 = __builtin_amdgcn_mfma_f32_32x32x16_bf16(pa[ks], v0, O0, 0, 0, 0); O1 = __builtin_amdgcn_mfma_f32_32x32x16_bf16(pa[ks], v1, O1, 0, 0, 0); } \
        } while (0)
        DIFF_MAP(0, m0, l0, oa0, oa1);
        DIFF_MAP(2, m1, l1, ob0, ob1);
#undef DIFF_MAP
    }
    l0 = half_sum(l0); l1 = half_sum(l1);
    if (hi == 0) { wsf[r32] = 1.f / l0; wsf[32 + r32] = lam / l1; }
    asm volatile("s_waitcnt lgkmcnt(0)" ::: "memory");
    const float g0 = norm_g[r32] * outscale, g1 = norm_g[32 + r32] * outscale;
    LAS unsigned short* stg = (LAS unsigned short*)(lds + LDS_OST) + wid * 2048;
#pragma unroll
    for (int r = 0; r < 16; ++r) {
        const int orow = crow(r, hi);
        const float f0 = wsf[orow], f1 = wsf[32 + orow];
        float v0 = oa0[r] * f0 - ob0[r] * f1, v1 = oa1[r] * f0 - ob1[r] * f1;
        float ss = v0 * v0 + v1 * v1;
#pragma unroll
        for (int o = 1; o < 32; o <<= 1) ss += __shfl_xor(ss, o);
        const float sc = 1.f / sqrtf(ss * (1.f / 64.f) + LN_EPS);
        stg[orow * 64 + r32] = (unsigned short)f2bf(v0 * sc * g0); stg[orow * 64 + 32 + r32] = (unsigned short)f2bf(v1 * sc * g1);
    }
    asm volatile("s_waitcnt lgkmcnt(0)" ::: "memory");
    bf16* Ow = ATT + (rowbase + qw) * D + h * 64;
#pragma unroll
    for (int i = 0; i < 4; ++i) { const int row = i * 8 + (lane >> 3), ch = lane & 7; const u32x4 v = *(LAS const u32x4*)(stg + row * 64 + ch * 8); *(GAS u32x4*)(Ow + (size_t)row * D + ch * 8) = v; }
    __syncthreads();
}

__device__ __forceinline__ void na_unit(const bf16* PROJ, bf16* ATT, int b, int hg, int gr, LAS char* lds) {
    int tid_l = threadIdx.x; asm volatile("" : "+v"(tid_l)); const int tid = tid_l, lane = tid & 63, r32 = lane & 31, hi = lane >> 5; const int wid = __builtin_amdgcn_readfirstlane(tid >> 6);
    const int hl = wid >> 1, qh = wid & 1, hh = hg * 4 + hl;
    LAS char* Kl = lds + LDS_K; LAS char* Vl = lds + LDS_V;
    LAS float* wsf = (LAS float*)(lds + LDS_WS) + wid * 64;
    LAS const float* rpb = (LAS const float*)(lds + LDS_RPB) + hh * 465;
    const size_t rowbase = (size_t)b * SEQ;
    const int cq = qh * 32 + r32;
    const bf16* Qp = PROJ + (rowbase + gr * 64 + cq) * NPROJ + 1536 + hh * 64 + hi * 8;
    bf16x8 qr[4];
#pragma unroll
    for (int d0 = 0; d0 < 4; ++d0) qr[d0] = *(const GAS bf16x8*)(Qp + d0 * 16);
    const int rs = min(max(gr - 4, 0), 24);
    const int cs = min(max(cq - 8, 0), 48);
    const bf16* ksrc = PROJ + (rowbase + (tid & 63)) * NPROJ + 2048 + hg * 256 + (tid >> 6) * 8;
    const bf16* vsrc = PROJ + (rowbase + 16 * (wid & 3) + (lane >> 2)) * NPROJ + 2560 + hg * 256 + (wid >> 2) * 32 + (lane & 3) * 8;
    float m = -1e30f, l = 0.f; f32x16 o0 = {}, o1 = {};
    const float sc = 0.125f * LOG2E;
    LAS const char* kb = Kl + hl * 8192 + hi * 1024 + r32 * 16;
    LAS const char* vp0 = Vl + hl * 8192 + ((lane >> 4) & 1) * 32 + (lane & 3) * 8 + (4 * hi + ((lane & 15) >> 2)) * 64;
    u32x4 kreg[4], vreg[4];
#pragma unroll
    for (int j = 0; j < 4; ++j) { kreg[j] = *(const GAS u32x4*)(ksrc + (size_t)rs * 64 * NPROJ + j * 64); vreg[j] = *(const GAS u32x4*)(vsrc + (size_t)rs * 64 * NPROJ + j * 64); }
#pragma unroll 1
    for (int i = 0; i < 8; ++i) {
        const int krow = rs + i;
        __syncthreads();
#pragma unroll
        for (int j = 0; j < 4; ++j) { *(LAS u32x4*)(Kl + j * 8192 + tid * 16) = kreg[j]; *(LAS u32x4*)(Vl + j * 8192 + tid * 16) = vreg[j]; }
        { const int kn = (i + 1 < 8) ? krow + 1 : krow;
#pragma unroll
          for (int j = 0; j < 4; ++j) { kreg[j] = *(const GAS u32x4*)(ksrc + (size_t)kn * 64 * NPROJ + j * 64); vreg[j] = *(const GAS u32x4*)(vsrc + (size_t)kn * 64 * NPROJ + j * 64); } }
        __syncthreads();
        f32x16 p0 = {}, p1 = {};
#pragma unroll
        for (int d0 = 0; d0 < 4; ++d0) {
            const bf16x8 a0 = *(LAS const bf16x8*)(kb + d0 * 2048), a1 = *(LAS const bf16x8*)(kb + d0 * 2048 + 512);
            p0 = __builtin_amdgcn_mfma_f32_32x32x16_bf16(a0, qr[d0], p0, 0, 0, 0); p1 = __builtin_amdgcn_mfma_f32_32x32x16_bf16(a1, qr[d0], p1, 0, 0, 0);
        }
        LAS const float* rp = rpb + (krow - gr + 7) * 31;
#pragma unroll
        for (int r = 0; r < 16; ++r) {
            const int ck0 = crow(r, hi), ck1 = ck0 + 32;
            const bool in0 = (ck0 >= cs) && (ck0 < cs + 16), in1 = (ck1 >= cs) && (ck1 < cs + 16);
            const float b0 = rp[in0 ? ck0 - cq + 15 : 0], b1 = rp[in1 ? ck1 - cq + 15 : 0];
            p0[r] = in0 ? p0[r] * sc + b0 : -1e30f; p1[r] = in1 ? p1[r] * sc + b1 : -1e30f;
        }
        bf16x8 pa[4];
        sm_update(p0, p1, 1.f, 0.f, m, l, o0, o1, wsf, r32, hi, pa);
#pragma unroll
        for (int ks = 0; ks < 4; ++ks) {
            const bf16x8 v0 = vfrag(vp0, ks * 1024), v1 = vfrag(vp0, 4096 + ks * 1024);
            o0 = __builtin_amdgcn_mfma_f32_32x32x16_bf16(pa[ks], v0, o0, 0, 0, 0); o1 = __builtin_amdgcn_mfma_f32_32x32x16_bf16(pa[ks], v1, o1, 0, 0, 0);
        }
    }
    l = half_sum(l);
    if (hi == 0) wsf[r32] = 1.f / l;
    asm volatile("s_waitcnt lgkmcnt(0)" ::: "memory");
    LAS unsigned short* stg = (LAS unsigned short*)(lds + LDS_OST) + wid * 2048;
#pragma unroll
    for (int r = 0; r < 16; ++r) { const int orow = crow(r, hi); const float f = wsf[orow]; stg[orow * 64 + r32] = (unsigned short)f2bf(o0[r] * f); stg[orow * 64 + 32 + r32] = (unsigned short)f2bf(o1[r] * f); }
    asm volatile("s_waitcnt lgkmcnt(0)" ::: "memory");
    bf16* Ow = ATT + (rowbase + gr * 64 + qh * 32) * D + 512 + hh * 64;
#pragma unroll
    for (int i = 0; i < 4; ++i) { const int row = i * 8 + (lane >> 3), ch = lane & 7; const u32x4 v = *(LAS const u32x4*)(stg + row * 64 + ch * 8); *(GAS u32x4*)(Ow + (size_t)row * D + ch * 8) = v; }
    __syncthreads();
}
}

namespace peer {
using att::bf16x8; using att::f32x16; using att::u32x4; using att::crow;
constexpr int LDS_KEYS = 0, LDS_IDX = 65536, LDS_G = 81920, LDS_PEER_END = 98304;
static_assert(LDS_PEER_END <= RING_BYTES, "peer LDS map");
__device__ __forceinline__ unsigned ford(float f) { const unsigned u = __float_as_uint(f); return u ^ (((unsigned)((int)u >> 31)) | 0x80000000u); }
__device__ __forceinline__ float fdec(unsigned k) { const unsigned u = (k & 0x80000000u) ? (k ^ 0x80000000u) : ~k; return __uint_as_float(u); }
template <int N> __device__ __forceinline__ void top16(const unsigned (&key)[N], unsigned (&a)[16]) {
    unsigned prev = 0xFFFFFFFFu;
#pragma unroll
    for (int i = 0; i < 16; ++i) a[i] = 0u;
#pragma unroll 1
    for (int p = 0; p < 16; ++p) {
        unsigned best = 0u;
#pragma unroll
        for (int i = 0; i < N; ++i) { const unsigned d = key[i] - prev; best = best > d ? best : d; }
        prev += best;
#pragma unroll
        for (int i = 0; i < 15; ++i) a[i] = a[i + 1];
        a[15] = prev;
    }
}
__device__ __forceinline__ void merge_halves(unsigned (&a)[16]) {
    unsigned c[16];
#pragma unroll
    for (int i = 0; i < 16; ++i) { const unsigned o = (unsigned)__shfl_xor((int)a[15 - i], 32); c[i] = a[i] > o ? a[i] : o; }
#pragma unroll
    for (int d = 8; d >= 1; d >>= 1)
#pragma unroll
        for (int i = 0; i < 16; ++i) if ((i & d) == 0) { const unsigned x = c[i], y = c[i + d]; c[i] = x > y ? x : y; c[i + d] = x > y ? y : x; }
#pragma unroll
    for (int i = 0; i < 16; ++i) a[i] = c[i];
}
__device__ __forceinline__ float gelu_erf(float v) { return 0.5f * v * (1.f + erff(v * 0.70710678118654752f)); }

__device__ __forceinline__ void route_unit(const bf16* QP, int* IDX, float* GW, int t0, LAS char* lds) {
    int tid_l = threadIdx.x; asm volatile("" : "+v"(tid_l)); const int tid = tid_l, lane = tid & 63, r32 = lane & 31, hi = lane >> 5; const int wid = __builtin_amdgcn_readfirstlane(tid >> 6);
    LAS const char* keysL = lds + LDS_KEYS;
    unsigned A[16], B[16];
#pragma unroll 1
    for (int half = 0; half < 2; ++half) {
        const bf16* qp = QP + (size_t)(t0 + r32) * NQP + wid * 256 + half * 128 + hi * 8;
        bf16x8 qf[8];
#pragma unroll
        for (int d0 = 0; d0 < 8; ++d0) qf[d0] = *(const GAS bf16x8*)(qp + d0 * 16);
        f32x16 acc[4] = {};
        LAS const char* kp = keysL + half * 32768 + hi * 2048 + r32 * 16;
#pragma unroll
        for (int kt = 0; kt < 4; ++kt)
#pragma unroll
            for (int d0 = 0; d0 < 8; ++d0) { const bf16x8 a = *(LAS const bf16x8*)(kp + d0 * 4096 + kt * 512); acc[kt] = __builtin_amdgcn_mfma_f32_32x32x16_bf16(a, qf[d0], acc[kt], 0, 0, 0); }
        unsigned key[64];
#pragma unroll
        for (int kt = 0; kt < 4; ++kt)
#pragma unroll
            for (int r = 0; r < 16; ++r) key[kt * 16 + r] = (ford(acc[kt][r]) & ~127u) | (unsigned)(127 - (kt * 32 + (r & 3) + 8 * (r >> 2)) - 4 * hi);
        unsigned a[16];
        top16<64>(key, a);
        merge_halves(a);
#pragma unroll
        for (int i = 0; i < 16; ++i) { if (half == 0) A[i] = a[i]; else B[i] = a[i]; }
    }
    {
        float fa[16], fb[16];
#pragma unroll
        for (int i = 0; i < 16; ++i) { fa[i] = fdec(A[i]); fb[i] = fdec(B[i]); }
        unsigned ck[50]; int n = 0;
#pragma unroll
        for (int i = 0; i < 16; ++i)
#pragma unroll
            for (int j = 0; j < 16; ++j) if ((i + 1) * (j + 1) <= 16) { ck[n] = (ford(fa[i] + fb[j]) & ~255u) | (unsigned)(255 - (i * 16 + j)); ++n; }
        unsigned w[16];
        top16<50>(ck, w);
        const unsigned thr = w[15]; const float smax = fdec(w[0]);
        float sum = 0.f; n = 0;
#pragma unroll
        for (int i = 0; i < 16; ++i)
#pragma unroll
            for (int j = 0; j < 16; ++j) if ((i + 1) * (j + 1) <= 16) { const float e = (ck[n] >= thr) ? __builtin_amdgcn_exp2f((fa[i] + fb[j] - smax) * LOG2E) : 0.f; sum += e; ++n; }
        const float inv = 1.f / sum;
        int pos = 0; n = 0;
        int* io = IDX + (size_t)(t0 + r32) * 128 + wid * 16; float* go = GW + (size_t)(t0 + r32) * 128 + wid * 16;
#pragma unroll
        for (int i = 0; i < 16; ++i)
#pragma unroll
            for (int j = 0; j < 16; ++j) if ((i + 1) * (j + 1) <= 16) {
                if (ck[n] >= thr && hi == 0) { io[pos] = (127 - (int)(A[i] & 127u)) * 128 + (127 - (int)(B[j] & 127u)); go[pos] = __builtin_amdgcn_exp2f((fa[i] + fb[j] - smax) * LOG2E) * inv; }
                pos += (ck[n] >= thr) ? 1 : 0; ++n; }
    }
}
__device__ __forceinline__ void peer_dot_phase(const unsigned char* UQ, const unsigned char* XQ, const int* IDX, int* HP, int grp, int wrank, int nw, int lane) {
    const int p = lane >> 3, k = lane & 7;
    const unsigned char* ub = UQ + (size_t)grp * NEXP * 128 + k * 16;
    const unsigned char* xb = XQ + (size_t)grp * M * 128 + k * 16;
    int* hb = HP + (size_t)grp * M * 128 + p;
#define PA_LDIDX(T, E) do { _Pragma("unroll") for (int i = 0; i < 16; ++i) E[i] = *(const GAS int*)(IDX + (size_t)(T) * 128 + i * 8 + p); } while (0)
#define PA_LDROWS(T, E, ROW, XQV) do { XQV = *(const GAS v4u*)(xb + (size_t)(T) * 128); _Pragma("unroll") for (int i = 0; i < 16; ++i) ROW[i] = *(const GAS v4u*)(ub + (size_t)E[i] * 128); } while (0)
#define PA_COMPUTE(T, ROW, XQV) do { int* hp = hb + (size_t)(T) * 128; _Pragma("unroll") for (int i = 0; i < 16; ++i) { \
            int d = __builtin_amdgcn_sdot4((int)ROW[i].x, (int)XQV.x, 0, false); d = __builtin_amdgcn_sdot4((int)ROW[i].y, (int)XQV.y, d, false); \
            d = __builtin_amdgcn_sdot4((int)ROW[i].z, (int)XQV.z, d, false); d = __builtin_amdgcn_sdot4((int)ROW[i].w, (int)XQV.w, d, false); \
            d += __shfl_xor(d, 1); d += __shfl_xor(d, 2); d += __shfl_xor(d, 4); \
            if (k == 0) *(GAS int*)(hp + i * 8) = d; } } while (0)
    int eA[16], eB[16]; v4u rowA[16], rowB[16]; v4u xqA, xqB;
    int t = wrank;
    PA_LDIDX(t, eA); PA_LDROWS(t, eA, rowA, xqA); PA_LDIDX(t + nw, eB);
#pragma unroll 1
    for (; t < M; t += 2 * nw) {
        const int t1 = t + nw, t2 = (t + 2 * nw < M) ? t + 2 * nw : t, t3 = (t + 3 * nw < M) ? t + 3 * nw : t1;
        PA_LDROWS(t1, eB, rowB, xqB);
        PA_LDIDX(t2, eA);
        PA_COMPUTE(t, rowA, xqA);
        PA_LDROWS(t2, eA, rowA, xqA);
        PA_LDIDX(t3, eB);
        PA_COMPUTE(t1, rowB, xqB);
    }
#undef PA_LDIDX
#undef PA_LDROWS
#undef PA_COMPUTE
}
__device__ __forceinline__ void peer_w_phase(const float* US, const float* VS, const float* XS, const int* IDX, const float* GW, const int* HP, float* WV, size_t gt, size_t ngt) {
    for (size_t i = gt; i < (size_t)M * 128; i += ngt) {
        const int e = *(const GAS int*)(IDX + i); const float g = *(const GAS float*)(GW + i);
        int isum = 0;
#pragma unroll
        for (int j = 0; j < 8; ++j) isum += *(const GAS int*)(HP + (size_t)j * M * 128 + i);
        const float h = (float)isum * (US[e] * XS[i >> 7]);
        *(GAS float*)(WV + i) = g * gelu_erf(h) * VS[e];
    }
}
typedef float f32x2 __attribute__((ext_vector_type(2)));
__device__ __forceinline__ void peer_acc_phase(const unsigned char* VQ, const int* IDX, const float* WV, float* F, int grp, int wrank, int nw, int lane) {
    const int p = lane >> 3, k = lane & 7;
    const unsigned char* vb = VQ + (size_t)grp * NEXP * 128 + k * 16;
#define PB_LDMETA(T, E2, W2) do { const size_t so = (size_t)(T) * 128 + lane; E2[0] = *(const GAS int*)(IDX + so); E2[1] = *(const GAS int*)(IDX + so + 64); \
            W2[0] = *(const GAS float*)(WV + so); W2[1] = *(const GAS float*)(WV + so + 64); } while (0)
#define PB_LDROWS(E2, W2, ROW, WI, WS) do { WS = wave_sum(W2[0] + W2[1]); _Pragma("unroll") for (int i = 0; i < 16; ++i) { const int src = (i * 8 + p) & 63; \
            const int ei = __shfl(E2[i >> 3], src); WI[i] = __shfl(W2[i >> 3], src); ROW[i] = *(const GAS v4u*)(vb + (size_t)ei * 128); } } while (0)
#define PB_COMPUTE(T, ROW, WI, WS) do { f32x2 acc[8]; _Pragma("unroll") for (int x = 0; x < 8; ++x) acc[x] = (f32x2){0.f, 0.f}; \
            _Pragma("unroll") for (int i = 0; i < 16; ++i) { const f32x2 wv = (f32x2){WI[i], WI[i]}; \
                _Pragma("unroll") for (int c = 0; c < 4; ++c) { const unsigned dw = ROW[i][c]; \
                    acc[2 * c] += wv * (f32x2){(float)(dw & 0xffu), (float)((dw >> 8) & 0xffu)}; acc[2 * c + 1] += wv * (f32x2){(float)((dw >> 16) & 0xffu), (float)(dw >> 24)}; } } \
            float o[16]; _Pragma("unroll") for (int x = 0; x < 8; ++x) { o[2 * x] = acc[x].x; o[2 * x + 1] = acc[x].y; } \
            _Pragma("unroll") for (int x = 0; x < 16; ++x) { float a = o[x]; a += __shfl_xor(a, 8); a += __shfl_xor(a, 16); a += __shfl_xor(a, 32); o[x] = a - 128.f * WS; } \
            if (p == 0) { float* fo = F + (size_t)(T) * D + grp * 128 + k * 16; \
                _Pragma("unroll") for (int c = 0; c < 4; ++c) *(GAS f32x4*)(fo + 4 * c) = (f32x4){o[4 * c], o[4 * c + 1], o[4 * c + 2], o[4 * c + 3]}; } } while (0)
    int e2A[2], e2B[2]; float w2A[2], w2B[2]; v4u rowA[16], rowB[16]; float wiA[16], wiB[16]; float wsA, wsB;
    int t = wrank;
    PB_LDMETA(t, e2A, w2A); PB_LDROWS(e2A, w2A, rowA, wiA, wsA); PB_LDMETA(t + nw, e2B, w2B);
#pragma unroll 1
    for (; t < M; t += 2 * nw) {
        const int t1 = t + nw, t2 = (t + 2 * nw < M) ? t + 2 * nw : t, t3 = (t + 3 * nw < M) ? t + 3 * nw : t1;
        PB_LDROWS(e2B, w2B, rowB, wiB, wsB);
        PB_LDMETA(t2, e2A, w2A);
        PB_COMPUTE(t, rowA, wiA, wsA);
        PB_LDROWS(e2A, w2A, rowA, wiA, wsA);
        PB_LDMETA(t3, e2B, w2B);
        PB_COMPUTE(t1, rowB, wiB, wsB);
    }
#undef PB_LDMETA
#undef PB_LDROWS
#undef PB_COMPUTE
}
}

struct Args { const float* in[18]; float* out; unsigned char* ws; int ph_lo, ph_hi; };
__global__ void __launch_bounds__(NWAVES * 64, 2) fwd_kernel(Args args) {
    extern __shared__ __attribute__((aligned(16))) unsigned char lds_raw[];
    LAS unsigned char* lds = (LAS unsigned char*)lds_raw;
    volatile LAS unsigned* MISC = (volatile LAS unsigned*)(lds + MISC_OFF);
    const int tid0 = threadIdx.x; const int wave = __builtin_amdgcn_readfirstlane(tid0 >> 6);
#define PHASE_TID() int tid = threadIdx.x; asm volatile("" : "+v"(tid)); const int lane = tid & 63; (void)lane
    const int G = gridDim.x; const int bx = blockIdx.x; const int vcu = (G % 8 == 0) ? (bx % 8) * (G / 8) + bx / 8 : bx;
    unsigned char* ws = args.ws;
    gu32* ctl = (gu32*)(ws + WS_CTL);
    for (int u = tid0; u < (LDS_BYTES - LDSCTL_OFF) / 4; u += NWAVES * 64) ((LAS unsigned*)(lds + LDSCTL_OFF))[u] = 0u;
    __syncthreads();
    XcdBarrier bar; bar.bar = (unsigned*)(ctl + CW_BAR); bar.x = 0; bar.st = nullptr;
    if (N_LAUNCHES == 1) bar = xcd_barrier_post((unsigned*)(ctl + CW_BAR), MISC + 8);
    const int lo = args.ph_lo, hi = args.ph_hi;
#ifndef PHMASK
#define PHMASK 0x37ff
#endif
#define EN(j) ((PHMASK >> (j)) & 1)
#ifndef DUPMASK
#define DUPMASK 0
#endif
#define NREP(j) (1 + ((DUPMASK >> (j)) & 1))
#define IN(k) (lo <= (k) && (k) < hi)
#define BOTH(k) (IN(k) && IN((k) + 1))
#define GRID_BAR() do { if (N_LAUNCHES == 1) xcd_barrier(bar); } while (0)
    const float* x_in = args.in[0];
    bf16* WIN = (bf16*)(ws + WS_WIN); bf16* WOUT = (bf16*)(ws + WS_WOUT); bf16* WQ = (bf16*)(ws + WS_WQ); bf16* KEYSB = (bf16*)(ws + WS_KEYS);
    unsigned char* UQ = ws + WS_UQ; unsigned char* VQ = ws + WS_VQ; float* US = (float*)(ws + WS_US); float* VS = (float*)(ws + WS_VS); unsigned char* XQ = ws + WS_XQ; float* XS = (float*)(ws + WS_XS);
    int* IDX = (int*)(ws + WS_IDX); float* GW = (float*)(ws + WS_GW); int* HP = (int*)(ws + WS_HP); float* WV = (float*)(ws + WS_WV); float* FB = (float*)(ws + WS_F); bf16* XB = (bf16*)(ws + WS_XB); bf16* PROJ = (bf16*)(ws + WS_PROJ); bf16* HB = (bf16*)(ws + WS_H);
    bf16* QP = (bf16*)(ws + WS_QP); bf16* ATT = (bf16*)(ws + WS_ATT); float* X1F = (float*)(ws + WS_X1F); bf16* X1B = (bf16*)(ws + WS_X1B);
    const int gw = vcu * NWAVES + wave, NGW = G * NWAVES;

    if (EN(0) && IN(0)) {
      _Pragma("unroll 1") for (int rep = 0; rep < NREP(0); ++rep) { if (rep) GRID_BAR();
        PHASE_TID();
        LAS float* scr = (LAS float*)(lds + wave * 16384);
        constexpr int I_IN = (D / 64) * (NPROJ / 32), I_OUT = (D / 64) * (D / 32), I_Q = (D / 64) * (NQP / 32), I_L = I_IN + I_OUT + I_Q;
        for (int it = gw; it < 2 * I_L; it += NGW) {
            const int l = it / I_L; int r = it % I_L;
            if (r < I_IN) { p0_transpose_item(args.in[1] + (size_t)l * D * NPROJ, D, NPROJ, WIN + (size_t)l * NPROJ * D, scr, r, lane); continue; } r -= I_IN;
            if (r < I_OUT) { p0_transpose_item(args.in[2] + (size_t)l * D * D, D, D, WOUT + (size_t)l * D * D, scr, r, lane); continue; } r -= I_OUT;
            p0_transpose_item(args.in[12] + (size_t)l * D * NQP, D, NQP, WQ + (size_t)l * NQP * D, scr, r, lane);
        }
        const size_t gt = (size_t)vcu * (NWAVES * 64) + tid, ngt = (size_t)G * NWAVES * 64;
        for (int r = gw; r < 2 * NEXP; r += NGW) {
            const int l = r / NEXP, e = r % NEXP;
            quant_row<0>(args.in[14] + (size_t)r * D, UQ + (size_t)l * NEXP * D, (size_t)e, US + r, lane);
            quant_row<128>(args.in[15] + (size_t)r * D, VQ + (size_t)l * NEXP * D, (size_t)e, VS + r, lane);
        }
        cvt_stream(x_in, XB, (size_t)M * D / 8, gt, ngt);
        cvt_stream(args.in[13], KEYSB, (size_t)2 * 2 * 128 * 128 / 8, gt, ngt);
      }
        if (BOTH(0)) GRID_BAR();
    }

#pragma unroll 1
    for (int l = 0; l < 2; ++l) {
        const int pb = 1 + 10 * l;
        const float* xres = (l == 0) ? x_in : args.out;
        if (EN(1) && IN(pb)) {
          _Pragma("unroll 1") for (int rep = 0; rep < NREP(1); ++rep) { if (rep) GRID_BAR();
            pg8::Gemm g{XB, WIN + (size_t)l * NPROJ * D, M, NPROJ, D}; pg8::StaticOrder S; S.init(M, NPROJ, G, bx);
            pg8::EpiBf16<0> E{PROJ, NPROJ, nullptr, 0, 0, 1.f};
            pg8::gemm_phase<pg8::EpiBf16<0>, pg8::StaticOrder, true, true>(lds, g, S, E);
          }
            if (BOTH(pb)) GRID_BAR();
        }
        if (EN(2) && IN(pb + 1)) {
          _Pragma("unroll 1") for (int rep = 0; rep < NREP(2); ++rep) { if (rep) GRID_BAR();
            PHASE_TID();
            float s1 = 0.f, s2 = 0.f;
            for (int i = 0; i < 32; ++i) { s1 += args.in[3][l * 32 + i] * args.in[4][l * 32 + i]; s2 += args.in[5][l * 32 + i] * args.in[6][l * 32 + i]; }
            const float lam_init = 0.8f - 0.6f * expf(-0.3f * (float)l);
            const float lam = expf(s1) - expf(s2) + lam_init;
            { LAS float* rp = (LAS float*)(lds + att::LDS_RPB); const float* src = args.in[9] + (size_t)l * 3720; for (int i = tid; i < 3720; i += NWAVES * 64) rp[i] = src[i] * LOG2E; }
            __syncthreads();
            if (EN(12)) for (int i = 0; i < 2; ++i) { const int u = vcu * 2 + i; if (u < 512) att::diff_unit(PROJ, ATT, (u >> 3) >> 3, (u >> 3) & 7, u & 7, (LAS char*)lds, args.in[8], lam, 1.f - lam_init, args.in[7] + l * 64); }
            if (EN(13)) for (int i = 0; i < 2; ++i) { const int u = vcu * 2 + i; if (u < 512) att::na_unit(PROJ, ATT, u >> 6, (u >> 5) & 1, u & 31, (LAS char*)lds); }
          }
            if (BOTH(pb + 1)) GRID_BAR();
        }
        if (EN(3) && IN(pb + 2)) {
          _Pragma("unroll 1") for (int rep = 0; rep < NREP(3); ++rep) { if (rep) GRID_BAR();
            pg8::Gemm g{ATT, WOUT + (size_t)l * D * D, M, D, D}; pg8::StaticOrder S; S.init(M, D, G, bx);
            pg8::EpiBf16<0> E{HB, D, nullptr, 0, 0, 1.f};
            pg8::gemm_phase<pg8::EpiBf16<0>, pg8::StaticOrder, true, true>(lds, g, S, E);
          }
            if (BOTH(pb + 2)) GRID_BAR();
        }
        if (EN(4) && IN(pb + 3)) {
          _Pragma("unroll 1") for (int rep = 0; rep < NREP(4); ++rep) { if (rep) GRID_BAR();
            PHASE_TID();
            for (int m = gw; m < M; m += NGW) ln1_row(xres + (size_t)m * D, HB + (size_t)m * D, args.in[10] + l * D, args.in[11] + l * D, X1F + (size_t)m * D, X1B + (size_t)m * D, XQ, XS, (size_t)m, lane);
          }
            if (BOTH(pb + 3)) GRID_BAR();
        }
        if (EN(5) && IN(pb + 4)) {
          _Pragma("unroll 1") for (int rep = 0; rep < NREP(5); ++rep) { if (rep) GRID_BAR();
            pg8::Gemm g{X1B, WQ + (size_t)l * NQP * D, M, NQP, D}; pg8::StaticOrder S; S.init(M, NQP, G, bx);
            pg8::EpiBf16<0> E{QP, NQP, nullptr, 0, 0, 1.f};
            pg8::gemm_phase<pg8::EpiBf16<0>, pg8::StaticOrder, true, true>(lds, g, S, E);
          }
            if (BOTH(pb + 4)) GRID_BAR();
        }
        if (EN(6) && IN(pb + 5)) {
          _Pragma("unroll 1") for (int rep = 0; rep < NREP(6); ++rep) { if (rep) GRID_BAR();
            PHASE_TID();
            { const bf16* ks = KEYSB + (size_t)l * 2 * 128 * 128;
              for (int p = tid; p < 4096; p += NWAVES * 64) { const int half = p >> 11, key = (p >> 4) & 127, chunk = p & 15;
                  *(LAS v4u*)(lds + peer::LDS_KEYS + half * 32768 + chunk * 2048 + key * 16) = *(const GAS v4u*)(ks + (size_t)p * 8); } }
            __syncthreads();
            for (int i = 0; i < 2; ++i) { const int u = vcu * 2 + i; if (u < 512) peer::route_unit(QP, IDX, GW, u * 32, (LAS char*)lds); }
            __syncthreads();
          }
            if (BOTH(pb + 5)) GRID_BAR();
        }
        if (EN(7) && IN(pb + 6)) {
          _Pragma("unroll 1") for (int rep = 0; rep < NREP(7); ++rep) { if (rep) GRID_BAR();
            PHASE_TID();
            peer::peer_dot_phase(UQ + (size_t)l * NEXP * D, XQ, IDX, HP, bx & 7, (bx >> 3) * NWAVES + wave, (G >> 3) * NWAVES, lane);
          }
            if (BOTH(pb + 6)) GRID_BAR();
        }
        if (EN(10) && IN(pb + 7)) {
          _Pragma("unroll 1") for (int rep = 0; rep < NREP(10); ++rep) { if (rep) GRID_BAR();
            PHASE_TID();
            peer::peer_w_phase(US + (size_t)l * NEXP, VS + (size_t)l * NEXP, XS, IDX, GW, HP, WV, (size_t)vcu * (NWAVES * 64) + tid, (size_t)G * NWAVES * 64);
          }
            if (BOTH(pb + 7)) GRID_BAR();
        }
        if (EN(8) && IN(pb + 8)) {
          _Pragma("unroll 1") for (int rep = 0; rep < NREP(8); ++rep) { if (rep) GRID_BAR();
            PHASE_TID();
            peer::peer_acc_phase(VQ + (size_t)l * NEXP * D, IDX, WV, FB, bx & 7, (bx >> 3) * NWAVES + wave, (G >> 3) * NWAVES, lane);
          }
            if (BOTH(pb + 8)) GRID_BAR();
        }
        if (EN(9) && IN(pb + 9)) {
          _Pragma("unroll 1") for (int rep = 0; rep < NREP(9); ++rep) { if (rep) GRID_BAR();
            PHASE_TID();
            for (int m = gw; m < M; m += NGW) ln2_row(X1F + (size_t)m * D, FB + (size_t)m * D, args.in[16] + l * D, args.in[17] + l * D, args.out + (size_t)m * D, XB + (size_t)m * D, lane);
          }
            if (BOTH(pb + 9)) GRID_BAR();
        }
    }
#undef IN
#undef BOTH
#undef GRID_BAR
}

extern "C" void kernel_launch(void* const* d_in, const int* in_sizes, int n_in, void* d_out, int out_size, void* d_ws, size_t ws_size, hipStream_t stream) {
    static int grid = 0;
    if (grid == 0) {
        if (n_in != 18 || in_sizes[0] != M * D || out_size != M * D || ws_size < WS_END) { fprintf(stderr, "kernel_launch: unexpected shapes (n_in %d, in0 %d, out %d, ws %zu); nothing launched\n", n_in, n_in > 0 ? in_sizes[0] : -1, out_size, ws_size); grid = -1; return; }
        int dev = 0, cus = 0, per_cu = 0;
        if (hipGetDevice(&dev) != hipSuccess || hipDeviceGetAttribute(&cus, hipDeviceAttributeMultiprocessorCount, dev) != hipSuccess) { grid = -1; return; }
        if (hipFuncSetAttribute((const void*)fwd_kernel, hipFuncAttributeMaxDynamicSharedMemorySize, LDS_BYTES) != hipSuccess) { fprintf(stderr, "kernel_launch: hipFuncSetAttribute failed\n"); grid = -1; return; }
        if (hipOccupancyMaxActiveBlocksPerMultiprocessor(&per_cu, (const void*)fwd_kernel, NWAVES * 64, LDS_BYTES) != hipSuccess || per_cu < 1) fprintf(stderr, "kernel_launch: occupancy query reports %d workgroups per CU\n", per_cu);
        (void)hipGetLastError();
        if (cus < 256) { fprintf(stderr, "kernel_launch: built for a 256-CU device (got %d); nothing launched\n", cus); grid = -1; return; }
        grid = 256;
    }
    if (grid < 0) return;
    if (hipMemsetAsync((char*)d_ws + WS_CTL, 0, CTL_ZERO_BYTES, stream) != hipSuccess) return;
    Args a{};
    for (int i = 0; i < 18; ++i) a.in[i] = (const float*)d_in[i];
    a.out = (float*)d_out; a.ws = (unsigned char*)d_ws;
    if (N_LAUNCHES == 1) { a.ph_lo = 0; a.ph_hi = NPH; hipLaunchKernelGGL(fwd_kernel, dim3(grid), dim3(NWAVES * 64), LDS_BYTES, stream, a); }
    else { for (int p = 0; p < NPH; ++p) { a.ph_lo = p; a.ph_hi = p + 1; hipLaunchKernelGGL(fwd_kernel, dim3(grid), dim3(NWAVES * 64), LDS_BYTES, stream, a); } }
}
```

```cpp
#include <hip/hip_runtime.h>
#include <cstdio>
#include <cstdint>
#include <cmath>
namespace pg8 {
#define PG8_LAS __attribute__((address_space(3)))
typedef unsigned short bf16_t;
typedef short bf16x8 __attribute__((ext_vector_type(8)));
typedef float f32x4 __attribute__((ext_vector_type(4)));
typedef unsigned u32x4 __attribute__((ext_vector_type(4)));
constexpr int BM = 256, BK = 64, HALF = 128, HTB = HALF * BK * 2  , STAGE_BYTES = 8 * HTB, NXCD = 8, WGM = 8;

__host__ __device__ __forceinline__ int lds_byte(int r, int c) { const int st = (r >> 4) * 2 + (c >> 5), rr = r & 15, cc = c & 31, ob = rr * 64 + cc * 2; return st * 1024 + (ob ^ (((ob >> 9) & 1) << 5)); }
__host__ __device__ __forceinline__ void stage_rc(int b, int& R, int& C) { const int st = b / 1024, sb = b % 1024, swz = sb ^ (((sb >> 9) & 1) << 5); R = (st >> 1) * 16 + swz / 64; C = (st & 1) * 32 + (swz % 64) / 2; }
__host__ __device__ __forceinline__ int perm32(int rho) { const int n = rho >> 4, i = rho & 15; return 8 * (i >> 2) + 4 * n + (i & 3); }

struct Unit { int pm, pn; };
struct Gemm { const bf16_t* A; const bf16_t* Bt; int M, N, K; };

struct StaticOrder {
    int nM, nN, nwg, G, c;
    __host__ __device__ void init(int M, int N, int G_, int c_) { nM = M / BM; nN = N / BM; nwg = nM * nN; G = G_; c = c_; }
    __host__ __device__ bool next(int i, Unit& u) const {
        const long L = (long)i * G + c; if (L >= nwg) return false;
        int wgid = (int)L; { const int q = nwg / NXCD, r = nwg % NXCD, xcd = wgid % NXCD, off = wgid / NXCD; wgid = (xcd < r ? xcd * (q + 1) : r * (q + 1) + (xcd - r) * q) + off; }
        const int nig = WGM * nN, gid = wgid / nig, fm = gid * WGM, gsz = (nM - fm) < WGM ? (nM - fm) : WGM;
        u.pm = fm + ((wgid % nig) % gsz); u.pn = (wgid % nig) / gsz; return true;
    }
    __device__ __forceinline__ void a_ready(const Unit&) const {}
    __device__ __forceinline__ void done(const Unit&) const {}
};

__device__ __forceinline__ unsigned cvt_pk_bf16(float lo, float hi) { unsigned r; asm volatile("v_cvt_pk_bf16_f32 %0, %1, %2" : "=v"(r) : "v"(lo), "v"(hi)); return r; }
typedef float f32x2 __attribute__((ext_vector_type(2)));
__device__ __forceinline__ f32x2 gelu_pk(f32x2 v) {
    const f32x2 av = __builtin_elementwise_abs(v), d = av * 0.2316418882f + 1.0f;
    f32x2 t; t.x = __builtin_amdgcn_rcpf(d.x); t.y = __builtin_amdgcn_rcpf(d.y);
    f32x2 q = t * 0.5307027145f + (-0.7265760135f); q = q * t + 0.7107068705f; q = q * t + (-0.142248368f); q = q * t + 0.127414796f; q = q * t;
    const f32x2 s = (v * v) * (-0.72134752044f);
    f32x2 e; e.x = __builtin_amdgcn_exp2f(s.x); e.y = __builtin_amdgcn_exp2f(s.y);
    const f32x2 m = v * (q * e), r = v - m;
    f32x2 o; o.x = v.x < 0.f ? m.x : r.x; o.y = v.y < 0.f ? m.y : r.y; return o;
}

template <int ACT  > struct EpiBf16 {
    static constexpr bool PERM = true, AFTER_DRAIN = false; static_assert(ACT == 0 || ACT == 1, "EpiBf16: ACT is 0 (none) or 1 (gelu_pk)");
    bf16_t* O; int ldc; const float* bias; int split_cols; size_t split_stride; float scale0;
    __device__ __forceinline__ void operator()(const f32x4 (&acc)[2][2][4][2], const Unit& u, int wr, int wc, int fr, int fq) const {
        const int row0 = u.pm * BM + wr * 64 + fr; int colt = u.pn * BM; bf16_t* base = O;
        float sc = 1.f; if (split_cols) { const int t = colt / split_cols; base += (size_t)t * split_stride; colt -= t * split_cols; if (t == 0) sc = scale0; }
        const int col0 = colt + wc * 32 + 8 * fq, bcol0 = u.pn * BM + wc * 32 + 8 * fq;
        f32x4 bv[2][2];
#pragma unroll
        for (int bj = 0; bj < 2; ++bj)
#pragma unroll
            for (int n = 0; n < 2; ++n) bv[bj][n] = bias ? *(const f32x4*)(bias + bcol0 + bj * HALF + 4 * n) : (f32x4){0.f, 0.f, 0.f, 0.f};
#pragma unroll
        for (int ai = 0; ai < 2; ++ai)
#pragma unroll
            for (int m = 0; m < 4; ++m) { bf16_t* rowp = base + (size_t)(row0 + ai * HALF + m * 16) * ldc + col0;
#pragma unroll
                for (int bj = 0; bj < 2; ++bj) { f32x4 v0 = acc[ai][bj][m][0] + bv[bj][0], v1 = acc[ai][bj][m][1] + bv[bj][1];
                    if (ACT == 1) { f32x2 a = gelu_pk((f32x2){v0[0], v0[1]}), b = gelu_pk((f32x2){v0[2], v0[3]}), c = gelu_pk((f32x2){v1[0], v1[1]}), d = gelu_pk((f32x2){v1[2], v1[3]});
                        v0 = (f32x4){a.x, a.y, b.x, b.y}; v1 = (f32x4){c.x, c.y, d.x, d.y}; }
                    v0 = v0 * sc; v1 = v1 * sc; u32x4 w; w.x = cvt_pk_bf16(v0[0], v0[1]); w.y = cvt_pk_bf16(v0[2], v0[3]); w.z = cvt_pk_bf16(v1[0], v1[1]); w.w = cvt_pk_bf16(v1[2], v1[3]);
                    *(u32x4*)(rowp + bj * HALF) = w; } }
    }
};
template <class Epi, class Sched, bool ALIGN_EPI = false, bool SP2 = false>
__device__ __forceinline__ void gemm_phase(PG8_LAS unsigned char* lds, const Gemm g, const Sched& S, const Epi& E) {
    int tid_l = threadIdx.x; asm volatile("" : "+v"(tid_l));
    const int tid = tid_l, wid = __builtin_amdgcn_readfirstlane(tid >> 6), lane = tid & 63, wr = wid >> 2, wc = wid & 3, fr = lane & 15, fq = lane >> 4;
    const int K = g.K, nt = K / BK;
    unsigned voffA[2], voffB[2];
#pragma unroll
    for (int i = 0; i < 2; ++i) { int R, C; stage_rc(tid * 16 + i * 8192, R, C); const int Rb = Epi::PERM ? ((R & ~31) + perm32(R & 31)) : R;
        voffA[i] = (unsigned)(R * K + C) * 2u; voffB[i] = (unsigned)(Rb * K + C) * 2u; }
    const size_t kstep = (size_t)(BK * 2);
    const size_t hstep = (size_t)HALF * K * 2;
    const size_t tstep = 2 * hstep;
    const unsigned ldsw = (unsigned)wid * 1024u;
    const int aoff = lds_byte(wr * 64 + fr, fq * 8), boff = lds_byte(wc * 32 + fr, fq * 8);
#define PG8_SA(b, h) (((b) * 2 + (h)) * HTB)
#define PG8_SB(b, h) ((4 + (b) * 2 + (h)) * HTB)
#define PG8_STAGE(bufoff, gbase, voff) do { _Pragma("unroll") for (int _i = 0; _i < 2; ++_i) \
        __builtin_amdgcn_global_load_lds((const unsigned*)((const char*)(gbase) + (voff)[_i]), (PG8_LAS unsigned*)(lds + (bufoff) + ldsw + _i * 8192), 16, 0, 0); } while (0)
#define PG8_LDA(dst, b, h) do { _Pragma("unroll") for (int m = 0; m < 4; ++m) _Pragma("unroll") for (int k = 0; k < 2; ++k) dst[m][k] = *(const PG8_LAS bf16x8*)(lds + PG8_SA(b, h) + aoff + m * 2048 + k * 1024); } while (0)
#define PG8_LDB(dst, b, h) do { _Pragma("unroll") for (int n = 0; n < 2; ++n) _Pragma("unroll") for (int k = 0; k < 2; ++k) dst[n][k] = *(const PG8_LAS bf16x8*)(lds + PG8_SB(b, h) + boff + n * 2048 + k * 1024); } while (0)
#define PG8_MMA(ai, bj, At, Bt) do { __builtin_amdgcn_s_setprio(1); _Pragma("unroll") for (int m = 0; m < 4; ++m) _Pragma("unroll") for (int n = 0; n < 2; ++n) _Pragma("unroll") for (int k = 0; k < 2; ++k) \
        acc[ai][bj][m][n] = __builtin_amdgcn_mfma_f32_16x16x32_bf16(Bt[n][k], At[m][k], acc[ai][bj][m][n], 0, 0, 0); __builtin_amdgcn_s_setprio(0); } while (0)
#define PG8_WAIT_V(n) asm volatile("s_waitcnt vmcnt(" #n ")" ::: "memory")
#define PG8_WAIT_L(n) asm volatile("s_waitcnt lgkmcnt(" #n ")" ::: "memory")
#define PG8_BAR __builtin_amdgcn_s_barrier()
#define PG8_SCHED __builtin_amdgcn_sched_barrier(0)
    Unit cur, nxt; int ui = 0;
    if (!S.next(0, cur)) return;
    f32x4 acc[2][2][4][2];
#pragma unroll
    for (int a = 0; a < 2; ++a)
#pragma unroll
        for (int b = 0; b < 2; ++b)
#pragma unroll
            for (int m = 0; m < 4; ++m)
#pragma unroll
                for (int n = 0; n < 2; ++n) acc[a][b][m][n] = (f32x4){0.f, 0.f, 0.f, 0.f};
    bf16x8 At[4][2], B0[2][2], B1[2][2];
    const char* cA = (const char*)g.A + (size_t)cur.pm * tstep; const char* cB = (const char*)g.Bt + (size_t)cur.pn * tstep;
    S.a_ready(cur);
    if constexpr (SP2) {
        PG8_STAGE(PG8_SB(0, 0), cB, voffB); PG8_STAGE(PG8_SB(0, 1), cB + hstep, voffB); PG8_STAGE(PG8_SA(0, 0), cA, voffA); PG8_STAGE(PG8_SA(0, 1), cA + hstep, voffA);
        if (wr == 1) PG8_BAR;
        PG8_WAIT_V(2); PG8_BAR;
        PG8_STAGE(PG8_SB(1, 0), cB + kstep, voffB); PG8_STAGE(PG8_SA(1, 0), cA + kstep, voffA); PG8_STAGE(PG8_SB(1, 1), cB + hstep + kstep, voffB);
        PG8_WAIT_V(6); PG8_BAR;
    } else {
        PG8_STAGE(PG8_SB(0, 0), cB, voffB); PG8_STAGE(PG8_SA(0, 0), cA, voffA); PG8_STAGE(PG8_SB(0, 1), cB + hstep, voffB); PG8_STAGE(PG8_SA(0, 1), cA + hstep, voffA);
        if (wr == 1) PG8_BAR;
        PG8_WAIT_V(4); PG8_BAR;
        PG8_STAGE(PG8_SB(1, 0), cB + kstep, voffB); PG8_STAGE(PG8_SA(1, 0), cA + kstep, voffA); PG8_STAGE(PG8_SB(1, 1), cB + hstep + kstep, voffB);
        PG8_WAIT_V(6); PG8_BAR;
    }
    for (;;) {
        const bool has_next = S.next(ui + 1, nxt);
        const char* nA = has_next ? (const char*)g.A + (size_t)nxt.pm * tstep : cA; const char* nB = has_next ? (const char*)g.Bt + (size_t)nxt.pn * tstep : cB;
        for (int t = 0; t < nt; t += 2) {
            const bool last = (t == nt - 2);
            const char* a1 = cA + (size_t)(t + 1) * kstep;
            const char* a2 = last ? nA : cA + (size_t)(t + 2) * kstep; const char* b2 = last ? nB : cB + (size_t)(t + 2) * kstep;
            const char* a3 = a2 + kstep; const char* b3 = b2 + kstep;
            if (last && has_next) S.a_ready(nxt);
            if constexpr (SP2) {
            PG8_LDB(B0, 0, 0); PG8_LDB(B1, 0, 1); PG8_SCHED; PG8_LDA(At, 0, 0); PG8_STAGE(PG8_SA(1, 1), a1 + hstep, voffA);
            PG8_WAIT_V(8); PG8_WAIT_L(0); PG8_BAR; PG8_MMA(0, 0, At, B0); PG8_MMA(0, 1, At, B1); PG8_BAR; PG8_SCHED;
            PG8_LDA(At, 0, 1); PG8_STAGE(PG8_SB(0, 0), b2, voffB); PG8_STAGE(PG8_SB(0, 1), b2 + hstep, voffB); PG8_STAGE(PG8_SA(0, 0), a2, voffA);
            PG8_WAIT_V(8); PG8_WAIT_L(0); PG8_BAR; PG8_MMA(1, 0, At, B0); PG8_MMA(1, 1, At, B1); PG8_BAR; PG8_SCHED;
            PG8_LDB(B0, 1, 0); PG8_LDB(B1, 1, 1); PG8_SCHED; PG8_LDA(At, 1, 0); PG8_STAGE(PG8_SA(0, 1), a2 + hstep, voffA);
            PG8_WAIT_V(8); PG8_WAIT_L(0); PG8_BAR; PG8_MMA(0, 0, At, B0); PG8_MMA(0, 1, At, B1); PG8_BAR; PG8_SCHED;
            PG8_LDA(At, 1, 1); PG8_STAGE(PG8_SB(1, 0), b3, voffB); PG8_STAGE(PG8_SB(1, 1), b3 + hstep, voffB); PG8_STAGE(PG8_SA(1, 0), a3, voffA);
            PG8_WAIT_V(8); PG8_WAIT_L(0); PG8_BAR; PG8_MMA(1, 0, At, B0); PG8_MMA(1, 1, At, B1); PG8_BAR; PG8_SCHED;
            } else {
            PG8_LDB(B0, 0, 0); PG8_SCHED; PG8_LDA(At, 0, 0); PG8_STAGE(PG8_SA(1, 1), a1 + hstep, voffA);
            PG8_WAIT_L(8); PG8_BAR; PG8_WAIT_L(0); PG8_MMA(0, 0, At, B0); PG8_BAR; PG8_SCHED;
            PG8_LDB(B1, 0, 1); PG8_STAGE(PG8_SB(0, 0), b2, voffB);
            PG8_BAR; PG8_WAIT_L(0); PG8_MMA(0, 1, At, B1); PG8_BAR;
            PG8_LDA(At, 0, 1); PG8_STAGE(PG8_SA(0, 0), a2, voffA);
            PG8_BAR; PG8_WAIT_L(0); PG8_MMA(1, 0, At, B0); PG8_BAR; PG8_SCHED;
            PG8_STAGE(PG8_SB(0, 1), b2 + hstep, voffB);
            PG8_WAIT_V(6); PG8_BAR; PG8_MMA(1, 1, At, B1); PG8_BAR;
            PG8_LDB(B0, 1, 0); PG8_SCHED; PG8_LDA(At, 1, 0); PG8_STAGE(PG8_SA(0, 1), a2 + hstep, voffA);
            PG8_WAIT_L(8); PG8_BAR; PG8_WAIT_L(0); PG8_MMA(0, 0, At, B0); PG8_BAR; PG8_SCHED;
            PG8_LDB(B1, 1, 1); PG8_STAGE(PG8_SB(1, 0), b3, voffB);
            PG8_BAR; PG8_WAIT_L(0); PG8_MMA(0, 1, At, B1); PG8_BAR;
            PG8_LDA(At, 1, 1); PG8_STAGE(PG8_SA(1, 0), a3, voffA);
            PG8_BAR; PG8_WAIT_L(0); PG8_MMA(1, 0, At, B0); PG8_BAR; PG8_SCHED;
            PG8_STAGE(PG8_SB(1, 1), b3 + hstep, voffB);
            PG8_WAIT_V(6); PG8_BAR; PG8_MMA(1, 1, At, B1); PG8_BAR;
            }
        }
        if constexpr (ALIGN_EPI) { if (wr == 0) PG8_BAR; }
        if constexpr (!Epi::AFTER_DRAIN) { E(acc, cur, wr, wc, fr, fq); S.done(cur); }
        if (!has_next) break;
#pragma unroll
        for (int a = 0; a < 2; ++a)
#pragma unroll
            for (int b = 0; b < 2; ++b)
#pragma unroll
                for (int m = 0; m < 4; ++m)
#pragma unroll
                    for (int n = 0; n < 2; ++n) acc[a][b][m][n] = (f32x4){0.f, 0.f, 0.f, 0.f};
        cur = nxt; cA = nA; cB = nB; ++ui;
        if constexpr (ALIGN_EPI) { if (wr == 1) PG8_BAR; }
    }
    PG8_WAIT_V(0);
    if constexpr (!ALIGN_EPI) { if (wr == 0) PG8_BAR; }
    PG8_BAR;
    if constexpr (Epi::AFTER_DRAIN) { E.fused(acc, cur, wr, wc, fr, fq, lds, wid, lane); S.done(cur); }
#undef PG8_SA
#undef PG8_SB
#undef PG8_STAGE
#undef PG8_LDA
#undef PG8_LDB
#undef PG8_MMA
#undef PG8_WAIT_V
#undef PG8_WAIT_L
#undef PG8_BAR
#undef PG8_SCHED
}
}
#define GAS __attribute__((address_space(1)))
#define LAS __attribute__((address_space(3)))
typedef unsigned short bf16;
typedef unsigned v4u __attribute__((ext_vector_type(4)));
typedef float f32x4 __attribute__((ext_vector_type(4)));
typedef short bf16x8 __attribute__((ext_vector_type(8)));
typedef GAS unsigned gu32;
typedef GAS unsigned long long gu64;
#define RLX_AGENT __ATOMIC_RELAXED, __HIP_MEMORY_SCOPE_AGENT
#define LDS_WAIT() asm volatile("s_waitcnt lgkmcnt(0)" ::: "memory")
#define VM_WAIT() asm volatile("s_waitcnt vmcnt(0)" ::: "memory")
__device__ __forceinline__ unsigned long long rt() { return __builtin_amdgcn_s_memrealtime(); }
__device__ __forceinline__ unsigned f2bf(float f) { unsigned u = __builtin_bit_cast(unsigned, f); return (u + 0x7fffu + ((u >> 16) & 1u)) >> 16; }
__device__ __forceinline__ unsigned pk2(float lo, float hi) { return f2bf(lo) | (f2bf(hi) << 16); }
#define XB_TMO      128
#define XB_XCNT(j)  (256  + 64 * (j))
#define XB_XSUB(j)  (1280 + 64 * (j))
#define XB_XGEN(j)  (2304 + 64 * (j))
#define XB_TOP      3328
#define XB_TOPGEN   3392
#define XCD_BAR_WORDS 3456
#define XB_SPIN_CAP (1u << 18)

__device__ __forceinline__ unsigned xb_ld(unsigned* p)              { return __hip_atomic_load(p, __ATOMIC_RELAXED, __HIP_MEMORY_SCOPE_AGENT); }
__device__ __forceinline__ unsigned xb_add(unsigned* p, unsigned v) { return __hip_atomic_fetch_add(p, v, __ATOMIC_RELAXED, __HIP_MEMORY_SCOPE_AGENT); }
__device__ __forceinline__ unsigned xb_xcc_id() { return (unsigned)__builtin_amdgcn_s_getreg((3 << 11) | 20) & 0xFu; }
#define XB_SPIN(cond, bar) do { unsigned _sp = 0; while (cond) { __builtin_amdgcn_s_sleep(1); \
    if ((++_sp & 255u) == 0u) { if (xb_ld(&(bar)[XB_TMO])) break; if (_sp > XB_SPIN_CAP) { atomicAdd(&(bar)[XB_TMO], 1u); break; } } } } while (0)

struct XcdBarrier {
    unsigned* bar; unsigned x;
    volatile LAS unsigned* st;
};

__device__ __forceinline__ XcdBarrier xcd_barrier_post(unsigned* bar, volatile LAS unsigned* st) {
    XcdBarrier b; b.bar = bar; b.x = xb_xcc_id(); b.st = st;
    if (threadIdx.x == 0) (void)xb_add(&bar[XB_XCNT(b.x)], 1u);
    return b;
}
__device__ __forceinline__ void xcd_barrier_complete(unsigned* bar, unsigned x, unsigned& nloc, unsigned& nx) {
    const unsigned G = gridDim.x * gridDim.y * gridDim.z;
    unsigned sum, cnt, mine, sp = 0u;
    for (;;) {
        sum = 0u; cnt = 0u; mine = 0u;
#pragma unroll
        for (unsigned j = 0; j < 16; ++j) { const unsigned c = xb_ld(&bar[XB_XCNT(j)]); sum += c; cnt += (c > 0u) ? 1u : 0u; mine = (j == x) ? c : mine; }
        if (sum == G) break;
        __builtin_amdgcn_s_sleep(1);
        if ((++sp & 255u) == 0u) { if (xb_ld(&bar[XB_TMO])) break; if (sp > XB_SPIN_CAP) { atomicAdd(&bar[XB_TMO], 1u); break; } }
    }
    nloc = mine > 0u ? mine : 1u; nx = cnt > 0u ? cnt : 1u;
}

__device__ __forceinline__ void xcd_barrier(const XcdBarrier& b) {
    asm volatile("s_waitcnt vmcnt(0)" ::: "memory");
    __syncthreads();
    if (threadIdx.x == 0) {
        unsigned* bar = b.bar;
        __builtin_amdgcn_s_waitcnt(0);
        unsigned nloc = b.st[0], nx = b.st[1];
        if (nloc == 0u) { xcd_barrier_complete(bar, b.x, nloc, nx); b.st[0] = nloc; b.st[1] = nx; }
        const unsigned old = xb_add(&bar[XB_XSUB(b.x)], 1u);
        const unsigned gen = old / nloc;
        if (old + 1u == (gen + 1u) * nloc) {
            __builtin_amdgcn_fence(__ATOMIC_RELEASE, "agent");
            asm volatile("s_waitcnt vmcnt(0)" ::: "memory");
            const unsigned og = xb_add(&bar[XB_TOP], 1u);
            const unsigned tg = og / nx;
            if (og + 1u == (tg + 1u) * nx) xb_add(&bar[XB_TOPGEN], 1u);
            else XB_SPIN(xb_ld(&bar[XB_TOPGEN]) == tg, bar);
            __builtin_amdgcn_fence(__ATOMIC_ACQUIRE, "agent");
            xb_add(&bar[XB_XGEN(b.x)], 1u);
            asm volatile("s_waitcnt vmcnt(0)" ::: "memory");
        } else {
            XB_SPIN(xb_ld(&bar[XB_XGEN(b.x)]) == gen, bar);
            __builtin_amdgcn_fence(__ATOMIC_ACQUIRE, "agent");
            asm volatile("s_waitcnt vmcnt(0)" ::: "memory");
        }
    }
    __syncthreads();
}

constexpr int NWAVES = 8;
constexpr int BATCH = 8, SEQ = 2048, D = 1024, M = BATCH * SEQ, NPROJ = 3072, NQP = 2048, NEXP = 16384;
constexpr float LN_EPS = 1e-5f, LOG2E = 1.4426950408889634f, ALPHA = 1.4142135623730951f;
#ifndef MK_N_LAUNCHES
#define MK_N_LAUNCHES 1
#endif
constexpr int NPH = 21;
constexpr int N_LAUNCHES = MK_N_LAUNCHES;

constexpr size_t MiB = 1u << 20;
constexpr size_t WS_CTL = 0, CTL_ZERO_BYTES = 1 * MiB;
constexpr size_t WS_WIN = 2 * MiB;
constexpr size_t WS_WOUT = 14 * MiB;
constexpr size_t WS_WQ = 18 * MiB;
constexpr size_t WS_KEYS = 26 * MiB;
constexpr size_t WS_UQ = 28 * MiB;
constexpr size_t WS_VQ = 60 * MiB;
constexpr size_t WS_US = 92 * MiB;
constexpr size_t WS_VS = 92 * MiB + 256 * 1024;
constexpr size_t WS_XQ = 93 * MiB;
constexpr size_t WS_XS = 109 * MiB;
constexpr size_t WS_IDX = 110 * MiB;
constexpr size_t WS_GW = 118 * MiB;
constexpr size_t WS_WV = 446 * MiB;
constexpr size_t WS_XB = 126 * MiB;
constexpr size_t WS_PROJ = 158 * MiB;
constexpr size_t WS_H = 158 * MiB;
constexpr size_t WS_QP = 190 * MiB;
constexpr size_t WS_F = 190 * MiB;
constexpr size_t WS_ATT = 254 * MiB;
constexpr size_t WS_X1F = 286 * MiB;
constexpr size_t WS_X1B = 350 * MiB;
constexpr size_t WS_HP = 382 * MiB;
constexpr size_t WS_END = 454 * MiB;
constexpr int CW_BAR = 4096;

constexpr int RING_BYTES = 131072, LDSCTL_OFF = RING_BYTES, MISC_OFF = LDSCTL_OFF + 320, LDS_BYTES = 147456;

__device__ __forceinline__ float bf2f(unsigned u16) { return __uint_as_float(u16 << 16); }
__device__ __forceinline__ float wave_sum(float v) {
#pragma unroll
    for (int o = 1; o < 64; o <<= 1) v += __shfl_xor(v, o);
    return v;
}

__device__ __forceinline__ void p0_transpose_item(const float* W, int K, int N, bf16* WT, LAS float* scr, int item, int lane) {
    const int nblk = N / 32, kb = item / nblk, nb = item % nblk, k0 = 64 * kb, n0 = 32 * nb;
#pragma unroll 8
    for (int i = 0; i < 32; ++i) { const int kk = 2 * i + (lane >> 5); scr[kk * 33 + (lane & 31)] = W[(size_t)(k0 + kk) * N + n0 + (lane & 31)]; }
    LDS_WAIT(); asm volatile("" ::: "memory");
    const int c = lane & 7;
#pragma unroll
    for (int j = 0; j < 4; ++j) { const int n = (lane >> 3) + 8 * j; const LAS float* s = scr + (8 * c) * 33 + n;
        v4u o; o.x = pk2(s[0 * 33], s[1 * 33]); o.y = pk2(s[2 * 33], s[3 * 33]); o.z = pk2(s[4 * 33], s[5 * 33]); o.w = pk2(s[6 * 33], s[7 * 33]);
        *(GAS v4u*)(WT + (size_t)(n0 + n) * K + k0 + 8 * c) = o; }
    LDS_WAIT(); asm volatile("" ::: "memory");
}
__device__ __forceinline__ void cvt_stream(const float* src, bf16* dst, size_t n8, size_t gt, size_t ngt) {
    for (size_t c = gt; c < n8; c += ngt) {
        const f32x4 a = *(const GAS f32x4*)(src + c * 8), b = *(const GAS f32x4*)(src + c * 8 + 4);
        v4u o; o.x = pk2(a.x, a.y); o.y = pk2(a.z, a.w); o.z = pk2(b.x, b.y); o.w = pk2(b.z, b.w);
        *(GAS v4u*)(dst + c * 8) = o;
    }
}
__device__ __forceinline__ float wave_max(float v) {
#pragma unroll
    for (int o = 1; o < 64; o <<= 1) v = fmaxf(v, __shfl_xor(v, o));
    return v;
}
template <int OFS> __device__ __forceinline__ void quant_row(const float* row, unsigned char* qbase, size_t e, float* scale_out, int lane) {
    f32x4 v[4]; float am = 0.f;
#pragma unroll
    for (int i = 0; i < 4; ++i) { v[i] = ((const GAS f32x4*)row)[lane * 4 + i]; am = fmaxf(am, fmaxf(fmaxf(fabsf(v[i].x), fabsf(v[i].y)), fmaxf(fabsf(v[i].z), fabsf(v[i].w)))); }
    am = wave_max(am);
    const float inv = am > 0.f ? 127.f / am : 0.f;
    v4u o;
#pragma unroll
    for (int i = 0; i < 4; ++i) {
        const int q0 = (int)rintf(v[i].x * inv) + OFS, q1 = (int)rintf(v[i].y * inv) + OFS, q2 = (int)rintf(v[i].z * inv) + OFS, q3 = (int)rintf(v[i].w * inv) + OFS;
        o[i] = (unsigned)(q0 & 0xff) | ((unsigned)(q1 & 0xff) << 8) | ((unsigned)(q2 & 0xff) << 16) | ((unsigned)(q3 & 0xff) << 24);
    }
    *(GAS v4u*)(qbase + ((size_t)(lane >> 3) * NEXP + e) * 128 + (lane & 7) * 16) = o;
    if (lane == 0) *scale_out = am > 0.f ? am * (1.f / 127.f) : 1.f;
}
__device__ __forceinline__ void ln1_row(const float* xrow, const bf16* hrow, const float* g, const float* bt, float* of, bf16* ob, unsigned char* xq, float* xs, size_t m, int lane) {
    f32x4 v[4]; float s = 0.f;
#pragma unroll
    for (int j = 0; j < 4; ++j) {
        const f32x4 xv = ((const GAS f32x4*)xrow)[lane + 64 * j];
        const unsigned long long hw = ((const GAS unsigned long long*)hrow)[lane + 64 * j];
        const unsigned lo = (unsigned)hw, hi = (unsigned)(hw >> 32);
        v[j].x = xv.x * ALPHA + bf2f(lo & 0xffffu); v[j].y = xv.y * ALPHA + bf2f(lo >> 16);
        v[j].z = xv.z * ALPHA + bf2f(hi & 0xffffu); v[j].w = xv.w * ALPHA + bf2f(hi >> 16);
        s += (v[j].x + v[j].y) + (v[j].z + v[j].w);
    }
    const float mean = wave_sum(s) * (1.f / D); float s2 = 0.f;
#pragma unroll
    for (int j = 0; j < 4; ++j) { v[j] = v[j] - mean; s2 += (v[j].x * v[j].x + v[j].y * v[j].y) + (v[j].z * v[j].z + v[j].w * v[j].w); }
    const float rstd = 1.f / sqrtf(wave_sum(s2) * (1.f / D) + LN_EPS);
    float am = 0.f;
#pragma unroll
    for (int j = 0; j < 4; ++j) {
        const f32x4 gv = ((const GAS f32x4*)g)[lane + 64 * j], bv = ((const GAS f32x4*)bt)[lane + 64 * j];
        const f32x4 o = v[j] * rstd * gv + bv; v[j] = o;
        ((GAS f32x4*)of)[lane + 64 * j] = o;
        ((GAS unsigned long long*)ob)[lane + 64 * j] = (unsigned long long)pk2(o.x, o.y) | ((unsigned long long)pk2(o.z, o.w) << 32);
        am = fmaxf(am, fmaxf(fmaxf(fabsf(o.x), fabsf(o.y)), fmaxf(fabsf(o.z), fabsf(o.w))));
    }
    am = wave_max(am);
    const float inv = am > 0.f ? 127.f / am : 0.f;
#pragma unroll
    for (int j = 0; j < 4; ++j) {
        const int q0 = (int)rintf(v[j].x * inv), q1 = (int)rintf(v[j].y * inv), q2 = (int)rintf(v[j].z * inv), q3 = (int)rintf(v[j].w * inv);
        const unsigned w = (unsigned)(q0 & 0xff) | ((unsigned)(q1 & 0xff) << 8) | ((unsigned)(q2 & 0xff) << 16) | ((unsigned)(q3 & 0xff) << 24);
        *(GAS unsigned*)(xq + ((size_t)(2 * j + (lane >> 5)) * M + m) * 128 + 4 * (lane & 31)) = w;
    }
    if (lane == 0) xs[m] = am > 0.f ? am * (1.f / 127.f) : 1.f;
}
__device__ __forceinline__ void ln2_row(const float* xrow, const float* frow, const float* g, const float* bt, float* of, bf16* ob, int lane) {
    f32x4 v[4]; float s = 0.f;
#pragma unroll
    for (int j = 0; j < 4; ++j) {
        const f32x4 xv = ((const GAS f32x4*)xrow)[lane + 64 * j], fv = ((const GAS f32x4*)frow)[lane + 64 * j];
        v[j] = xv * ALPHA + fv;
        s += (v[j].x + v[j].y) + (v[j].z + v[j].w);
    }
    const float mean = wave_sum(s) * (1.f / D); float s2 = 0.f;
#pragma unroll
    for (int j = 0; j < 4; ++j) { v[j] = v[j] - mean; s2 += (v[j].x * v[j].x + v[j].y * v[j].y) + (v[j].z * v[j].z + v[j].w * v[j].w); }
    const float rstd = 1.f / sqrtf(wave_sum(s2) * (1.f / D) + LN_EPS);
#pragma unroll
    for (int j = 0; j < 4; ++j) {
        const f32x4 gv = ((const GAS f32x4*)g)[lane + 64 * j], bv = ((const GAS f32x4*)bt)[lane + 64 * j];
        const f32x4 o = v[j] * rstd * gv + bv;
        ((GAS f32x4*)of)[lane + 64 * j] = o;
        ((GAS unsigned long long*)ob)[lane + 64 * j] = (unsigned long long)pk2(o.x, o.y) | ((unsigned long long)pk2(o.z, o.w) << 32);
    }
}

namespace att {
typedef short bf16x8 __attribute__((ext_vector_type(8)));
typedef short s16x4 __attribute__((ext_vector_type(4)));
typedef short v4i16_t __attribute__((ext_vector_type(4)));
typedef float f32x16 __attribute__((ext_vector_type(16)));
typedef unsigned u32x4 __attribute__((ext_vector_type(4)));
typedef float f32x2_t __attribute__((ext_vector_type(2)));
typedef __bf16 bf16x2_t __attribute__((ext_vector_type(2)));
constexpr int LDS_K = 0, LDS_V = 32768, LDS_WS = 65536, LDS_OST = 67584, LDS_T5 = 100352, LDS_RPB = 101632, LDS_ATT_END = LDS_RPB + 3720 * 4;
static_assert(LDS_ATT_END <= RING_BYTES, "attention LDS map");
__device__ __forceinline__ int crow(int r, int hi) { return (r & 3) + 8 * (r >> 2) + 4 * hi; }
__device__ __forceinline__ unsigned cvtpk(float lo, float hi) { f32x2_t v = {lo, hi}; bf16x2_t b = __builtin_convertvector(v, bf16x2_t); return __builtin_bit_cast(unsigned, b); }
__device__ __forceinline__ bf16x8 pack8(const f32x16& P, int B) {
    u32x4 w; w.x = cvtpk(P[B], P[B + 1]); w.y = cvtpk(P[B + 2], P[B + 3]); w.z = cvtpk(P[B + 4], P[B + 5]); w.w = cvtpk(P[B + 6], P[B + 7]);
    return __builtin_bit_cast(bf16x8, w);
}
__device__ __forceinline__ float half_max(float v) { auto rr = __builtin_amdgcn_permlane32_swap(__float_as_uint(v), __float_as_uint(v), false, false); return fmaxf(__uint_as_float(rr[0]), __uint_as_float(rr[1])); }
__device__ __forceinline__ float half_sum(float v) { auto rr = __builtin_amdgcn_permlane32_swap(__float_as_uint(v), __float_as_uint(v), false, false); return __uint_as_float(rr[0]) + __uint_as_float(rr[1]); }
__device__ __forceinline__ s16x4 vtr(LAS const char* p) { return __builtin_bit_cast(s16x4, __builtin_amdgcn_ds_read_tr16_b64_v4i16((LAS v4i16_t*)p)); }
__device__ __forceinline__ bf16x8 vfrag(LAS const char* vp, int off) { const s16x4 lo = vtr(vp + off), hi = vtr(vp + off + 512); return (bf16x8){lo[0], lo[1], lo[2], lo[3], hi[0], hi[1], hi[2], hi[3]}; }

__device__ __forceinline__ float max3f(float a, float b, float c) { float r; asm("v_max3_f32 %0, %1, %2, %3" : "=v"(r) : "v"(a), "v"(b), "v"(c)); return r; }
__device__ __forceinline__ float max2f(float a, float b) { float r; asm("v_max_f32_e32 %0, %1, %2" : "=v"(r) : "v"(a), "v"(b)); return r; }
__device__ __forceinline__ void sm_update(const f32x16& p0, const f32x16& p1, float c, float off, float& m, float& l, f32x16& o0, f32x16& o1, LAS float* wsf, int r32, int hi, bf16x8 (&pa)[4]) {
    float a = max3f(p0[0], p0[1], p1[0]), b = max3f(p0[2], p0[3], p1[1]); a = max3f(a, p1[2], p1[3]);
#pragma unroll
    for (int r = 4; r < 16; r += 4) { a = max3f(a, p0[r], p0[r + 1]); b = max3f(b, p0[r + 2], p0[r + 3]); a = max3f(a, p1[r], p1[r + 1]); b = max3f(b, p1[r + 2], p1[r + 3]); }
    float mx = max2f(a, b);
    { auto rr = __builtin_amdgcn_permlane32_swap(__float_as_uint(mx), __float_as_uint(mx), false, false); mx = max2f(__uint_as_float(rr[0]), __uint_as_float(rr[1])); }
    mx = mx * c + off;
    if (__any(mx > m + 8.f)) {
        const float mn = fmaxf(m, mx);
        const float al = __builtin_amdgcn_exp2f(m - mn);
        m = mn; l *= al;
        if (hi == 0) wsf[r32] = al;
        asm volatile("s_waitcnt lgkmcnt(0)" ::: "memory");
#pragma unroll
        for (int r = 0; r < 16; ++r) { const float f = wsf[crow(r, hi)]; o0[r] *= f; o1[r] *= f; }
        asm volatile("s_waitcnt lgkmcnt(0)" ::: "memory");
    }
    const float nb = off - m;
    float sA = 0.f, sB = 0.f;
    u32x4 w[4];
#pragma unroll
    for (int g = 0; g < 4; ++g)
#pragma unroll
        for (int q = 0; q < 4; ++q) {
            const int r = (g & 1) * 8 + 2 * q;
            const float x0 = (g < 2) ? p0[r] : p1[r], x1 = (g < 2) ? p0[r + 1] : p1[r + 1];
            const float e0 = __builtin_amdgcn_exp2f(__builtin_fmaf(x0, c, nb)), e1 = __builtin_amdgcn_exp2f(__builtin_fmaf(x1, c, nb));
            sA += e0; sB += e1;
            w[g][q] = cvtpk(e0, e1);
        }
    l += sA + sB;
    pa[0] = __builtin_bit_cast(bf16x8, w[0]); pa[1] = __builtin_bit_cast(bf16x8, w[1]); pa[2] = __builtin_bit_cast(bf16x8, w[2]); pa[3] = __builtin_bit_cast(bf16x8, w[3]);
}
__device__ __forceinline__ int t5_bucket_idx(int rel) {
    const int n = rel < 0 ? -rel : rel; const int base = rel > 0 ? 16 : 0;
    int v;
    if (n < 8) v = n; else if (n < 12) v = 8; else if (n < 16) v = 9; else if (n < 23) v = 10; else if (n < 32) v = 11; else if (n < 46) v = 12; else if (n < 64) v = 13; else if (n < 91) v = 14; else v = 15;
    return base + v;
}

__device__ __forceinline__ void diff_unit(const bf16* PROJ, bf16* ATT, int b, int h, int qb, LAS char* lds, const float* t5_bias, float lam, float outscale, const float* norm_g) {
    int tid_l = threadIdx.x; asm volatile("" : "+v"(tid_l)); const int tid = tid_l, lane = tid & 63, r32 = lane & 31, hi = lane >> 5; const int wid = __builtin_amdgcn_readfirstlane(tid >> 6);
    LAS char* Kl = lds + LDS_K; LAS char* Vl = lds + LDS_V;
    LAS float* wsf = (LAS float*)(lds + LDS_WS) + wid * 64;
    LAS float* t5 = (LAS float*)(lds + LDS_T5);
    if (tid < 257) t5[tid] = t5_bias[t5_bucket_idx(tid - 128) * 8 + h] * LOG2E;
    const size_t rowbase = (size_t)b * SEQ;
    const int qw = qb * 256 + wid * 32;
    const bf16* Qp = PROJ + (rowbase + qw + r32) * NPROJ + h * 64 + hi * 8;
    bf16x8 qr[4];
#pragma unroll
    for (int d0 = 0; d0 < 4; ++d0) qr[d0] = *(const GAS bf16x8*)(Qp + d0 * 16);
    const bf16* ksrc = PROJ + (rowbase + (tid & 63)) * NPROJ + 512 + h * 64 + (tid >> 6) * 8;
    const bf16* vsrc = PROJ + (rowbase + 16 * (wid & 3) + (lane >> 2)) * NPROJ + 1024 + h * 64 + (wid >> 2) * 32 + (lane & 3) * 8;
    float m0 = -1e30f, m1 = -1e30f, l0 = 0.f, l1 = 0.f;
    f32x16 oa0 = {}, oa1 = {}, ob0 = {}, ob1 = {};
    const float c = 0.17677669529663687f * LOG2E;
    LAS const char* kb = Kl + hi * 1024 + r32 * 16;
    LAS const char* vp0 = Vl + ((lane >> 4) & 1) * 32 + (lane & 3) * 8 + (4 * hi + ((lane & 15) >> 2)) * 64;
    u32x4 kreg = *(const GAS u32x4*)ksrc, vreg = *(const GAS u32x4*)vsrc;
    *(LAS u32x4*)(Kl + tid * 16) = kreg; *(LAS u32x4*)(Vl + tid * 16) = vreg;
    kreg = *(const GAS u32x4*)(ksrc + (size_t)64 * NPROJ); vreg = *(const GAS u32x4*)(vsrc + (size_t)64 * NPROJ);
#pragma unroll 1
    for (int t = 0; t < SEQ / 64; ++t) {
        const int cur = (t & 1) * 8192, nxt = 8192 - cur;
        __syncthreads();
        if (t + 1 < SEQ / 64) { *(LAS u32x4*)(Kl + nxt + tid * 16) = kreg; *(LAS u32x4*)(Vl + nxt + tid * 16) = vreg; }
        { const int t2 = (t + 2 < SEQ / 64) ? t + 2 : t; kreg = *(const GAS u32x4*)(ksrc + (size_t)t2 * 64 * NPROJ); vreg = *(const GAS u32x4*)(vsrc + (size_t)t2 * 64 * NPROJ); }
        const int kv0 = t * 64;
        const int rel_lo = kv0 - (qw + 31), rel_hi = kv0 + 63 - qw;
        const bool far = (rel_hi <= -91 || rel_lo >= 91);
        const float bc = far ? ((rel_lo >= 91) ? t5[256] : t5[0]) : 0.f;
        const int relb = kv0 + 4 * hi - (qw + r32);
#define DIFF_MAP(DB, MM, LL, O0, O1) do { \
        __builtin_amdgcn_sched_barrier(0); \
        f32x16 s0 = {}, s1 = {}; \
        _Pragma("unroll") for (int d0 = (DB); d0 < (DB) + 2; ++d0) { \
            const bf16x8 a0 = *(LAS const bf16x8*)(kb + cur + d0 * 2048), a1 = *(LAS const bf16x8*)(kb + cur + d0 * 2048 + 512); \
            s0 = __builtin_amdgcn_mfma_f32_32x32x16_bf16(a0, qr[d0], s0, 0, 0, 0); s1 = __builtin_amdgcn_mfma_f32_32x32x16_bf16(a1, qr[d0], s1, 0, 0, 0); } \
        asm volatile("s_nop 15\n\ts_nop 7" : "+v"(s0), "+v"(s1));     \
        bf16x8 pa[4]; \
        if (far) sm_update(s0, s1, c, bc, MM, LL, O0, O1, wsf, r32, hi, pa); \
        else { int relo = relb; asm volatile("" : "+v"(relo)); _Pragma("unroll") for (int r = 0; r < 16; ++r) { const int rel = relo + (r & 3) + 8 * (r >> 2); \
                const int i0 = min(max(rel, -128), 128) + 128, i1 = min(max(rel + 32, -128), 128) + 128; \
                s0[r] = s0[r] * c + t5[i0]; s1[r] = s1[r] * c + t5[i1]; } \
            sm_update(s0, s1, 1.f, 0.f, MM, LL, O0, O1, wsf, r32, hi, pa); } \
        __builtin_amdgcn_sched_barrier(0); \
        _Pragma("unroll") for (int ks = 0; ks < 4; ++ks) { \
            const bf16x8 v0 = vfrag(vp0 + cur, ks * 1024), v1 = vfrag(vp0 + cur, 4096 + ks * 1024); \
            O0 = __builtin_amdgcn_mfma_f32_32x32x16_bf16(pa[ks], v0, O0, 0, 0, 0); O1 = __builtin_amdgcn_mfma_f32_32x32x16_bf16(pa[ks], v1, O1, 0, 0, 0); } \
        } while (0)
        DIFF_MAP(0, m0, l0, oa0, oa1);
        DIFF_MAP(2, m1, l1, ob0, ob1);
#undef DIFF_MAP
    }
    l0 = half_sum(l0); l1 = half_sum(l1);
    if (hi == 0) { wsf[r32] = 1.f / l0; wsf[32 + r32] = lam / l1; }
    asm volatile("s_waitcnt lgkmcnt(0)" ::: "memory");
    const float g0 = norm_g[r32] * outscale, g1 = norm_g[32 + r32] * outscale;
    LAS unsigned short* stg = (LAS unsigned short*)(lds + LDS_OST) + wid * 2048;
#pragma unroll
    for (int r = 0; r < 16; ++r) {
        const int orow = crow(r, hi);
        const float f0 = wsf[orow], f1 = wsf[32 + orow];
        float v0 = oa0[r] * f0 - ob0[r] * f1, v1 = oa1[r] * f0 - ob1[r] * f1;
        float ss = v0 * v0 + v1 * v1;
#pragma unroll
        for (int o = 1; o < 32; o <<= 1) ss += __shfl_xor(ss, o);
        const float sc = 1.f / sqrtf(ss * (1.f / 64.f) + LN_EPS);
        stg[orow * 64 + r32] = (unsigned short)f2bf(v0 * sc * g0); stg[orow * 64 + 32 + r32] = (unsigned short)f2bf(v1 * sc * g1);
    }
    asm volatile("s_waitcnt lgkmcnt(0)" ::: "memory");
    bf16* Ow = ATT + (rowbase + qw) * D + h * 64;
#pragma unroll
    for (int i = 0; i < 4; ++i) { const int row = i * 8 + (lane >> 3), ch = lane & 7; const u32x4 v = *(LAS const u32x4*)(stg + row * 64 + ch * 8); *(GAS u32x4*)(Ow + (size_t)row * D + ch * 8) = v; }
    __syncthreads();
}

__device__ __forceinline__ void na_unit(const bf16* PROJ, bf16* ATT, int b, int hg, int gr, LAS char* lds) {
    int tid_l = threadIdx.x; asm volatile("" : "+v"(tid_l)); const int tid = tid_l, lane = tid & 63, r32 = lane & 31, hi = lane >> 5; const int wid = __builtin_amdgcn_readfirstlane(tid >> 6);
    const int hl = wid >> 1, qh = wid & 1, hh = hg * 4 + hl;
    LAS char* Kl = lds + LDS_K; LAS char* Vl = lds + LDS_V;
    LAS float* wsf = (LAS float*)(lds + LDS_WS) + wid * 64;
    LAS const float* rpb = (LAS const float*)(lds + LDS_RPB) + hh * 465;
    const size_t rowbase = (size_t)b * SEQ;
    const int cq = qh * 32 + r32;
    const bf16* Qp = PROJ + (rowbase + gr * 64 + cq) * NPROJ + 1536 + hh * 64 + hi * 8;
    bf16x8 qr[4];
#pragma unroll
    for (int d0 = 0; d0 < 4; ++d0) qr[d0] = *(const GAS bf16x8*)(Qp + d0 * 16);
    const int rs = min(max(gr - 4, 0), 24);
    const int cs = min(max(cq - 8, 0), 48);
    const bf16* ksrc = PROJ + (rowbase + (tid & 63)) * NPROJ + 2048 + hg * 256 + (tid >> 6) * 8;
    const bf16* vsrc = PROJ + (rowbase + 16 * (wid & 3) + (lane >> 2)) * NPROJ + 2560 + hg * 256 + (wid >> 2) * 32 + (lane & 3) * 8;
    float m = -1e30f, l = 0.f; f32x16 o0 = {}, o1 = {};
    const float sc = 0.125f * LOG2E;
    LAS const char* kb = Kl + hl * 8192 + hi * 1024 + r32 * 16;
    LAS const char* vp0 = Vl + hl * 8192 + ((lane >> 4) & 1) * 32 + (lane & 3) * 8 + (4 * hi + ((lane & 15) >> 2)) * 64;
    u32x4 kreg[4], vreg[4];
#pragma unroll
    for (int j = 0; j < 4; ++j) { kreg[j] = *(const GAS u32x4*)(ksrc + (size_t)rs * 64 * NPROJ + j * 64); vreg[j] = *(const GAS u32x4*)(vsrc + (size_t)rs * 64 * NPROJ + j * 64); }
#pragma unroll 1
    for (int i = 0; i < 8; ++i) {
        const int krow = rs + i;
        __syncthreads();
#pragma unroll
        for (int j = 0; j < 4; ++j) { *(LAS u32x4*)(Kl + j * 8192 + tid * 16) = kreg[j]; *(LAS u32x4*)(Vl + j * 8192 + tid * 16) = vreg[j]; }
        { const int kn = (i + 1 < 8) ? krow + 1 : krow;
#pragma unroll
          for (int j = 0; j < 4; ++j) { kreg[j] = *(const GAS u32x4*)(ksrc + (size_t)kn * 64 * NPROJ + j * 64); vreg[j] = *(const GAS u32x4*)(vsrc + (size_t)kn * 64 * NPROJ + j * 64); } }
        __syncthreads();
        f32x16 p0 = {}, p1 = {};
#pragma unroll
        for (int d0 = 0; d0 < 4; ++d0) {
            const bf16x8 a0 = *(LAS const bf16x8*)(kb + d0 * 2048), a1 = *(LAS const bf16x8*)(kb + d0 * 2048 + 512);
            p0 = __builtin_amdgcn_mfma_f32_32x32x16_bf16(a0, qr[d0], p0, 0, 0, 0); p1 = __builtin_amdgcn_mfma_f32_32x32x16_bf16(a1, qr[d0], p1, 0, 0, 0);
        }
        LAS const float* rp = rpb + (krow - gr + 7) * 31;
#pragma unroll
        for (int r = 0; r < 16; ++r) {
            const int ck0 = crow(r, hi), ck1 = ck0 + 32;
            const bool in0 = (ck0 >= cs) && (ck0 < cs + 16), in1 = (ck1 >= cs) && (ck1 < cs + 16);
            const float b0 = rp[in0 ? ck0 - cq + 15 : 0], b1 = rp[in1 ? ck1 - cq + 15 : 0];
            p0[r] = in0 ? p0[r] * sc + b0 : -1e30f; p1[r] = in1 ? p1[r] * sc + b1 : -1e30f;
        }
        bf16x8 pa[4];
        sm_update(p0, p1, 1.f, 0.f, m, l, o0, o1, wsf, r32, hi, pa);
#pragma unroll
        for (int ks = 0; ks < 4; ++ks) {
            const bf16x8 v0 = vfrag(vp0, ks * 1024), v1 = vfrag(vp0, 4096 + ks * 1024);
            o0 = __builtin_amdgcn_mfma_f32_32x32x16_bf16(pa[ks], v0, o0, 0, 0, 0); o1 = __builtin_amdgcn_mfma_f32_32x32x16_bf16(pa[ks], v1, o1, 0, 0, 0);
        }
    }
    l = half_sum(l);
    if (hi == 0) wsf[r32] = 1.f / l;
    asm volatile("s_waitcnt lgkmcnt(0)" ::: "memory");
    LAS unsigned short* stg = (LAS unsigned short*)(lds + LDS_OST) + wid * 2048;
#pragma unroll
    for (int r = 0; r < 16; ++r) { const int orow = crow(r, hi); const float f = wsf[orow]; stg[orow * 64 + r32] = (unsigned short)f2bf(o0[r] * f); stg[orow * 64 + 32 + r32] = (unsigned short)f2bf(o1[r] * f); }
    asm volatile("s_waitcnt lgkmcnt(0)" ::: "memory");
    bf16* Ow = ATT + (rowbase + gr * 64 + qh * 32) * D + 512 + hh * 64;
#pragma unroll
    for (int i = 0; i < 4; ++i) { const int row = i * 8 + (lane >> 3), ch = lane & 7; const u32x4 v = *(LAS const u32x4*)(stg + row * 64 + ch * 8); *(GAS u32x4*)(Ow + (size_t)row * D + ch * 8) = v; }
    __syncthreads();
}
}

namespace peer {
using att::bf16x8; using att::f32x16; using att::u32x4; using att::crow;
constexpr int LDS_KEYS = 0, LDS_IDX = 65536, LDS_G = 81920, LDS_PEER_END = 98304;
static_assert(LDS_PEER_END <= RING_BYTES, "peer LDS map");
__device__ __forceinline__ unsigned ford(float f) { const unsigned u = __float_as_uint(f); return u ^ (((unsigned)((int)u >> 31)) | 0x80000000u); }
__device__ __forceinline__ float fdec(unsigned k) { const unsigned u = (k & 0x80000000u) ? (k ^ 0x80000000u) : ~k; return __uint_as_float(u); }
template <int N> __device__ __forceinline__ void top16(const unsigned (&key)[N], unsigned (&a)[16]) {
    unsigned prev = 0xFFFFFFFFu;
#pragma unroll
    for (int i = 0; i < 16; ++i) a[i] = 0u;
#pragma unroll 1
    for (int p = 0; p < 16; ++p) {
        unsigned best = 0u;
#pragma unroll
        for (int i = 0; i < N; ++i) { const unsigned d = key[i] - prev; best = best > d ? best : d; }
        prev += best;
#pragma unroll
        for (int i = 0; i < 15; ++i) a[i] = a[i + 1];
        a[15] = prev;
    }
}
__device__ __forceinline__ void merge_halves(unsigned (&a)[16]) {
    unsigned c[16];
#pragma unroll
    for (int i = 0; i < 16; ++i) { const unsigned o = (unsigned)__shfl_xor((int)a[15 - i], 32); c[i] = a[i] > o ? a[i] : o; }
#pragma unroll
    for (int d = 8; d >= 1; d >>= 1)
#pragma unroll
        for (int i = 0; i < 16; ++i) if ((i & d) == 0) { const unsigned x = c[i], y = c[i + d]; c[i] = x > y ? x : y; c[i + d] = x > y ? y : x; }
#pragma unroll
    for (int i = 0; i < 16; ++i) a[i] = c[i];
}
__device__ __forceinline__ float gelu_erf(float v) { return 0.5f * v * (1.f + erff(v * 0.70710678118654752f)); }

__device__ __forceinline__ void route_unit(const bf16* QP, int* IDX, float* GW, int t0, LAS char* lds) {
    int tid_l = threadIdx.x; asm volatile("" : "+v"(tid_l)); const int tid = tid_l, lane = tid & 63, r32 = lane & 31, hi = lane >> 5; const int wid = __builtin_amdgcn_readfirstlane(tid >> 6);
    LAS const char* keysL = lds + LDS_KEYS;
    unsigned A[16], B[16];
#pragma unroll 1
    for (int half = 0; half < 2; ++half) {
        const bf16* qp = QP + (size_t)(t0 + r32) * NQP + wid * 256 + half * 128 + hi * 8;
        bf16x8 qf[8];
#pragma unroll
        for (int d0 = 0; d0 < 8; ++d0) qf[d0] = *(const GAS bf16x8*)(qp + d0 * 16);
        f32x16 acc[4] = {};
        LAS const char* kp = keysL + half * 32768 + hi * 2048 + r32 * 16;
#pragma unroll
        for (int kt = 0; kt < 4; ++kt)
#pragma unroll
            for (int d0 = 0; d0 < 8; ++d0) { const bf16x8 a = *(LAS const bf16x8*)(kp + d0 * 4096 + kt * 512); acc[kt] = __builtin_amdgcn_mfma_f32_32x32x16_bf16(a, qf[d0], acc[kt], 0, 0, 0); }
        unsigned key[64];
#pragma unroll
        for (int kt = 0; kt < 4; ++kt)
#pragma unroll
            for (int r = 0; r < 16; ++r) key[kt * 16 + r] = (ford(acc[kt][r]) & ~127u) | (unsigned)(127 - (kt * 32 + (r & 3) + 8 * (r >> 2)) - 4 * hi);
        unsigned a[16];
        top16<64>(key, a);
        merge_halves(a);
#pragma unroll
        for (int i = 0; i < 16; ++i) { if (half == 0) A[i] = a[i]; else B[i] = a[i]; }
    }
    {
        float fa[16], fb[16];
#pragma unroll
        for (int i = 0; i < 16; ++i) { fa[i] = fdec(A[i]); fb[i] = fdec(B[i]); }
        unsigned ck[50]; int n = 0;
#pragma unroll
        for (int i = 0; i < 16; ++i)
#pragma unroll
            for (int j = 0; j < 16; ++j) if ((i + 1) * (j + 1) <= 16) { ck[n] = (ford(fa[i] + fb[j]) & ~255u) | (unsigned)(255 - (i * 16 + j)); ++n; }
        unsigned w[16];
        top16<50>(ck, w);
        const unsigned thr = w[15]; const float smax = fdec(w[0]);
        float sum = 0.f; n = 0;
#pragma unroll
        for (int i = 0; i < 16; ++i)
#pragma unroll
            for (int j = 0; j < 16; ++j) if ((i + 1) * (j + 1) <= 16) { const float e = (ck[n] >= thr) ? __builtin_amdgcn_exp2f((fa[i] + fb[j] - smax) * LOG2E) : 0.f; sum += e; ++n; }
        const float inv = 1.f / sum;
        int pos = 0; n = 0;
        int* io = IDX + (size_t)(t0 + r32) * 128 + wid * 16; float* go = GW + (size_t)(t0 + r32) * 128 + wid * 16;
#pragma unroll
        for (int i = 0; i < 16; ++i)
#pragma unroll
            for (int j = 0; j < 16; ++j) if ((i + 1) * (j + 1) <= 16) {
                if (ck[n] >= thr && hi == 0) { io[pos] = (127 - (int)(A[i] & 127u)) * 128 + (127 - (int)(B[j] & 127u)); go[pos] = __builtin_amdgcn_exp2f((fa[i] + fb[j] - smax) * LOG2E) * inv; }
                pos += (ck[n] >= thr) ? 1 : 0; ++n; }
    }
}
__device__ __forceinline__ void peer_dot_phase(const unsigned char* UQ, const unsigned char* XQ, const int* IDX, int* HP, int grp, int wrank, int nw, int lane) {
    const int p = lane >> 3, k = lane & 7;
    const unsigned char* ub = UQ + (size_t)grp * NEXP * 128 + k * 16;
    const unsigned char* xb = XQ + (size_t)grp * M * 128 + k * 16;
    int* hb = HP + (size_t)grp * M * 128 + p;
#define PA_LDIDX(T, E) do { _Pragma("unroll") for (int i = 0; i < 16; ++i) E[i] = *(const GAS int*)(IDX + (size_t)(T) * 128 + i * 8 + p); } while (0)
#define PA_LDROWS(T, E, ROW, XQV) do { XQV = *(const GAS v4u*)(xb + (size_t)(T) * 128); _Pragma("unroll") for (int i = 0; i < 16; ++i) ROW[i] = *(const GAS v4u*)(ub + (size_t)E[i] * 128); } while (0)
#define PA_COMPUTE(T, ROW, XQV) do { int* hp = hb + (size_t)(T) * 128; _Pragma("unroll") for (int i = 0; i < 16; ++i) { \
            int d = __builtin_amdgcn_sdot4((int)ROW[i].x, (int)XQV.x, 0, false); d = __builtin_amdgcn_sdot4((int)ROW[i].y, (int)XQV.y, d, false); \
            d = __builtin_amdgcn_sdot4((int)ROW[i].z, (int)XQV.z, d, false); d = __builtin_amdgcn_sdot4((int)ROW[i].w, (int)XQV.w, d, false); \
            d += __shfl_xor(d, 1); d += __shfl_xor(d, 2); d += __shfl_xor(d, 4); \
            if (k == 0) *(GAS int*)(hp + i * 8) = d; } } while (0)
    int eA[16], eB[16]; v4u rowA[16], rowB[16]; v4u xqA, xqB;
    int t = wrank;
    PA_LDIDX(t, eA); PA_LDROWS(t, eA, rowA, xqA); PA_LDIDX(t + nw, eB);
#pragma unroll 1
    for (; t < M; t += 2 * nw) {
        const int t1 = t + nw, t2 = (t + 2 * nw < M) ? t + 2 * nw : t, t3 = (t + 3 * nw < M) ? t + 3 * nw : t1;
        PA_LDROWS(t1, eB, rowB, xqB);
        PA_LDIDX(t2, eA);
        PA_COMPUTE(t, rowA, xqA);
        PA_LDROWS(t2, eA, rowA, xqA);
        PA_LDIDX(t3, eB);
        PA_COMPUTE(t1, rowB, xqB);
    }
#undef PA_LDIDX
#undef PA_LDROWS
#undef PA_COMPUTE
}
__device__ __forceinline__ void peer_w_phase(const float* US, const float* VS, const float* XS, const int* IDX, const float* GW, const int* HP, float* WV, size_t gt, size_t ngt) {
    for (size_t i = gt; i < (size_t)M * 128; i += ngt) {
        const int e = *(const GAS int*)(IDX + i); const float g = *(const GAS float*)(GW + i);
        int isum = 0;
#pragma unroll
        for (int j = 0; j < 8; ++j) isum += *(const GAS int*)(HP + (size_t)j * M * 128 + i);
        const float h = (float)isum * (US[e] * XS[i >> 7]);
        *(GAS float*)(WV + i) = g * gelu_erf(h) * VS[e];
    }
}
typedef float f32x2 __attribute__((ext_vector_type(2)));
__device__ __forceinline__ void peer_acc_phase(const unsigned char* VQ, const int* IDX, const float* WV, float* F, int grp, int wrank, int nw, int lane) {
    const int p = lane >> 3, k = lane & 7;
    const unsigned char* vb = VQ + (size_t)grp * NEXP * 128 + k * 16;
#define PB_LDMETA(T, E2, W2) do { const size_t so = (size_t)(T) * 128 + lane; E2[0] = *(const GAS int*)(IDX + so); E2[1] = *(const GAS int*)(IDX + so + 64); \
            W2[0] = *(const GAS float*)(WV + so); W2[1] = *(const GAS float*)(WV + so + 64); } while (0)
#define PB_LDROWS(E2, W2, ROW, WI, WS) do { WS = wave_sum(W2[0] + W2[1]); _Pragma("unroll") for (int i = 0; i < 16; ++i) { const int src = (i * 8 + p) & 63; \
            const int ei = __shfl(E2[i >> 3], src); WI[i] = __shfl(W2[i >> 3], src); ROW[i] = *(const GAS v4u*)(vb + (size_t)ei * 128); } } while (0)
#define PB_COMPUTE(T, ROW, WI, WS) do { f32x2 acc[8]; _Pragma("unroll") for (int x = 0; x < 8; ++x) acc[x] = (f32x2){0.f, 0.f}; \
            _Pragma("unroll") for (int i = 0; i < 16; ++i) { const f32x2 wv = (f32x2){WI[i], WI[i]}; \
                _Pragma("unroll") for (int c = 0; c < 4; ++c) { const unsigned dw = ROW[i][c]; \
                    acc[2 * c] += wv * (f32x2){(float)(dw & 0xffu), (float)((dw >> 8) & 0xffu)}; acc[2 * c + 1] += wv * (f32x2){(float)((dw >> 16) & 0xffu), (float)(dw >> 24)}; } } \
            float o[16]; _Pragma("unroll") for (int x = 0; x < 8; ++x) { o[2 * x] = acc[x].x; o[2 * x + 1] = acc[x].y; } \
            _Pragma("unroll") for (int x = 0; x < 16; ++x) { float a = o[x]; a += __shfl_xor(a, 8); a += __shfl_xor(a, 16); a += __shfl_xor(a, 32); o[x] = a - 128.f * WS; } \
            if (p == 0) { float* fo = F + (size_t)(T) * D + grp * 128 + k * 16; \
                _Pragma("unroll") for (int c = 0; c < 4; ++c) *(GAS f32x4*)(fo + 4 * c) = (f32x4){o[4 * c], o[4 * c + 1], o[4 * c + 2], o[4 * c + 3]}; } } while (0)
    int e2A[2], e2B[2]; float w2A[2], w2B[2]; v4u rowA[16], rowB[16]; float wiA[16], wiB[16]; float wsA, wsB;
    int t = wrank;
    PB_LDMETA(t, e2A, w2A); PB_LDROWS(e2A, w2A, rowA, wiA, wsA); PB_LDMETA(t + nw, e2B, w2B);
#pragma unroll 1
    for (; t < M; t += 2 * nw) {
        const int t1 = t + nw, t2 = (t + 2 * nw < M) ? t + 2 * nw : t, t3 = (t + 3 * nw < M) ? t + 3 * nw : t1;
        PB_LDROWS(e2B, w2B, rowB, wiB, wsB);
        PB_LDMETA(t2, e2A, w2A);
        PB_COMPUTE(t, rowA, wiA, wsA);
        PB_LDROWS(e2A, w2A, rowA, wiA, wsA);
        PB_LDMETA(t3, e2B, w2B);
        PB_COMPUTE(t1, rowB, wiB, wsB);
    }
#undef PB_LDMETA
#undef PB_LDROWS
#undef PB_COMPUTE
}
}

struct Args { const float* in[18]; float* out; unsigned char* ws; int ph_lo, ph_hi; };
__global__ void __launch_bounds__(NWAVES * 64, 2) fwd_kernel(Args args) {
    extern __shared__ __attribute__((aligned(16))) unsigned char lds_raw[];
    LAS unsigned char* lds = (LAS unsigned char*)lds_raw;
    volatile LAS unsigned* MISC = (volatile LAS unsigned*)(lds + MISC_OFF);
    const int tid0 = threadIdx.x; const int wave = __builtin_amdgcn_readfirstlane(tid0 >> 6);
#define PHASE_TID() int tid = threadIdx.x; asm volatile("" : "+v"(tid)); const int lane = tid & 63; (void)lane
    const int G = gridDim.x; const int bx = blockIdx.x; const int vcu = (G % 8 == 0) ? (bx % 8) * (G / 8) + bx / 8 : bx;
    unsigned char* ws = args.ws;
    gu32* ctl = (gu32*)(ws + WS_CTL);
    for (int u = tid0; u < (LDS_BYTES - LDSCTL_OFF) / 4; u += NWAVES * 64) ((LAS unsigned*)(lds + LDSCTL_OFF))[u] = 0u;
    __syncthreads();
    XcdBarrier bar; bar.bar = (unsigned*)(ctl + CW_BAR); bar.x = 0; bar.st = nullptr;
    if (N_LAUNCHES == 1) bar = xcd_barrier_post((unsigned*)(ctl + CW_BAR), MISC + 8);
    const int lo = args.ph_lo, hi = args.ph_hi;
#ifndef PHMASK
#define PHMASK 0x37ff
#endif
#define EN(j) ((PHMASK >> (j)) & 1)
#ifndef DUPMASK
#define DUPMASK 0
#endif
#define NREP(j) (1 + ((DUPMASK >> (j)) & 1))
#define IN(k) (lo <= (k) && (k) < hi)
#define BOTH(k) (IN(k) && IN((k) + 1))
#define GRID_BAR() do { if (N_LAUNCHES == 1) xcd_barrier(bar); } while (0)
    const float* x_in = args.in[0];
    bf16* WIN = (bf16*)(ws + WS_WIN); bf16* WOUT = (bf16*)(ws + WS_WOUT); bf16* WQ = (bf16*)(ws + WS_WQ); bf16* KEYSB = (bf16*)(ws + WS_KEYS);
    unsigned char* UQ = ws + WS_UQ; unsigned char* VQ = ws + WS_VQ; float* US = (float*)(ws + WS_US); float* VS = (float*)(ws + WS_VS); unsigned char* XQ = ws + WS_XQ; float* XS = (float*)(ws + WS_XS);
    int* IDX = (int*)(ws + WS_IDX); float* GW = (float*)(ws + WS_GW); int* HP = (int*)(ws + WS_HP); float* WV = (float*)(ws + WS_WV); float* FB = (float*)(ws + WS_F); bf16* XB = (bf16*)(ws + WS_XB); bf16* PROJ = (bf16*)(ws + WS_PROJ); bf16* HB = (bf16*)(ws + WS_H);
    bf16* QP = (bf16*)(ws + WS_QP); bf16* ATT = (bf16*)(ws + WS_ATT); float* X1F = (float*)(ws + WS_X1F); bf16* X1B = (bf16*)(ws + WS_X1B);
    const int gw = vcu * NWAVES + wave, NGW = G * NWAVES;

    if (EN(0) && IN(0)) {
      _Pragma("unroll 1") for (int rep = 0; rep < NREP(0); ++rep) { if (rep) GRID_BAR();
        PHASE_TID();
        LAS float* scr = (LAS float*)(lds + wave * 16384);
        constexpr int I_IN = (D / 64) * (NPROJ / 32), I_OUT = (D / 64) * (D / 32), I_Q = (D / 64) * (NQP / 32), I_L = I_IN + I_OUT + I_Q;
        for (int it = gw; it < 2 * I_L; it += NGW) {
            const int l = it / I_L; int r = it % I_L;
            if (r < I_IN) { p0_transpose_item(args.in[1] + (size_t)l * D * NPROJ, D, NPROJ, WIN + (size_t)l * NPROJ * D, scr, r, lane); continue; } r -= I_IN;
            if (r < I_OUT) { p0_transpose_item(args.in[2] + (size_t)l * D * D, D, D, WOUT + (size_t)l * D * D, scr, r, lane); continue; } r -= I_OUT;
            p0_transpose_item(args.in[12] + (size_t)l * D * NQP, D, NQP, WQ + (size_t)l * NQP * D, scr, r, lane);
        }
        const size_t gt = (size_t)vcu * (NWAVES * 64) + tid, ngt = (size_t)G * NWAVES * 64;
        for (int r = gw; r < 2 * NEXP; r += NGW) {
            const int l = r / NEXP, e = r % NEXP;
            quant_row<0>(args.in[14] + (size_t)r * D, UQ + (size_t)l * NEXP * D, (size_t)e, US + r, lane);
            quant_row<128>(args.in[15] + (size_t)r * D, VQ + (size_t)l * NEXP * D, (size_t)e, VS + r, lane);
        }
        cvt_stream(x_in, XB, (size_t)M * D / 8, gt, ngt);
        cvt_stream(args.in[13], KEYSB, (size_t)2 * 2 * 128 * 128 / 8, gt, ngt);
      }
        if (BOTH(0)) GRID_BAR();
    }

#pragma unroll 1
    for (int l = 0; l < 2; ++l) {
        const int pb = 1 + 10 * l;
        const float* xres = (l == 0) ? x_in : args.out;
        if (EN(1) && IN(pb)) {
          _Pragma("unroll 1") for (int rep = 0; rep < NREP(1); ++rep) { if (rep) GRID_BAR();
            pg8::Gemm g{XB, WIN + (size_t)l * NPROJ * D, M, NPROJ, D}; pg8::StaticOrder S; S.init(M, NPROJ, G, bx);
            pg8::EpiBf16<0> E{PROJ, NPROJ, nullptr, 0, 0, 1.f};
            pg8::gemm_phase<pg8::EpiBf16<0>, pg8::StaticOrder, true, true>(lds, g, S, E);
          }
            if (BOTH(pb)) GRID_BAR();
        }
        if (EN(2) && IN(pb + 1)) {
          _Pragma("unroll 1") for (int rep = 0; rep < NREP(2); ++rep) { if (rep) GRID_BAR();
            PHASE_TID();
            float s1 = 0.f, s2 = 0.f;
            for (int i = 0; i < 32; ++i) { s1 += args.in[3][l * 32 + i] * args.in[4][l * 32 + i]; s2 += args.in[5][l * 32 + i] * args.in[6][l * 32 + i]; }
            const float lam_init = 0.8f - 0.6f * expf(-0.3f * (float)l);
            const float lam = expf(s1) - expf(s2) + lam_init;
            { LAS float* rp = (LAS float*)(lds + att::LDS_RPB); const float* src = args.in[9] + (size_t)l * 3720; for (int i = tid; i < 3720; i += NWAVES * 64) rp[i] = src[i] * LOG2E; }
            __syncthreads();
            if (EN(12)) for (int i = 0; i < 2; ++i) { const int u = vcu * 2 + i; if (u < 512) att::diff_unit(PROJ, ATT, (u >> 3) >> 3, (u >> 3) & 7, u & 7, (LAS char*)lds, args.in[8], lam, 1.f - lam_init, args.in[7] + l * 64); }
            if (EN(13)) for (int i = 0; i < 2; ++i) { const int u = vcu * 2 + i; if (u < 512) att::na_unit(PROJ, ATT, u >> 6, (u >> 5) & 1, u & 31, (LAS char*)lds); }
          }
            if (BOTH(pb + 1)) GRID_BAR();
        }
        if (EN(3) && IN(pb + 2)) {
          _Pragma("unroll 1") for (int rep = 0; rep < NREP(3); ++rep) { if (rep) GRID_BAR();
            pg8::Gemm g{ATT, WOUT + (size_t)l * D * D, M, D, D}; pg8::StaticOrder S; S.init(M, D, G, bx);
            pg8::EpiBf16<0> E{HB, D, nullptr, 0, 0, 1.f};
            pg8::gemm_phase<pg8::EpiBf16<0>, pg8::StaticOrder, true, true>(lds, g, S, E);
          }
            if (BOTH(pb + 2)) GRID_BAR();
        }
        if (EN(4) && IN(pb + 3)) {
          _Pragma("unroll 1") for (int rep = 0; rep < NREP(4); ++rep) { if (rep) GRID_BAR();
            PHASE_TID();
            for (int m = gw; m < M; m += NGW) ln1_row(xres + (size_t)m * D, HB + (size_t)m * D, args.in[10] + l * D, args.in[11] + l * D, X1F + (size_t)m * D, X1B + (size_t)m * D, XQ, XS, (size_t)m, lane);
          }
            if (BOTH(pb + 3)) GRID_BAR();
        }
        if (EN(5) && IN(pb + 4)) {
          _Pragma("unroll 1") for (int rep = 0; rep < NREP(5); ++rep) { if (rep) GRID_BAR();
            pg8::Gemm g{X1B, WQ + (size_t)l * NQP * D, M, NQP, D}; pg8::StaticOrder S; S.init(M, NQP, G, bx);
            pg8::EpiBf16<0> E{QP, NQP, nullptr, 0, 0, 1.f};
            pg8::gemm_phase<pg8::EpiBf16<0>, pg8::StaticOrder, true, true>(lds, g, S, E);
          }
            if (BOTH(pb + 4)) GRID_BAR();
        }
        if (EN(6) && IN(pb + 5)) {
          _Pragma("unroll 1") for (int rep = 0; rep < NREP(6); ++rep) { if (rep) GRID_BAR();
            PHASE_TID();
            { const bf16* ks = KEYSB + (size_t)l * 2 * 128 * 128;
              for (int p = tid; p < 4096; p += NWAVES * 64) { const int half = p >> 11, key = (p >> 4) & 127, chunk = p & 15;
                  *(LAS v4u*)(lds + peer::LDS_KEYS + half * 32768 + chunk * 2048 + key * 16) = *(const GAS v4u*)(ks + (size_t)p * 8); } }
            __syncthreads();
            for (int i = 0; i < 2; ++i) { const int u = vcu * 2 + i; if (u < 512) peer::route_unit(QP, IDX, GW, u * 32, (LAS char*)lds); }
            __syncthreads();
          }
            if (BOTH(pb + 5)) GRID_BAR();
        }
        if (EN(7) && IN(pb + 6)) {
          _Pragma("unroll 1") for (int rep = 0; rep < NREP(7); ++rep) { if (rep) GRID_BAR();
            PHASE_TID();
            peer::peer_dot_phase(UQ + (size_t)l * NEXP * D, XQ, IDX, HP, bx & 7, (bx >> 3) * NWAVES + wave, (G >> 3) * NWAVES, lane);
          }
            if (BOTH(pb + 6)) GRID_BAR();
        }
        if (EN(10) && IN(pb + 7)) {
          _Pragma("unroll 1") for (int rep = 0; rep < NREP(10); ++rep) { if (rep) GRID_BAR();
            PHASE_TID();
            peer::peer_w_phase(US + (size_t)l * NEXP, VS + (size_t)l * NEXP, XS, IDX, GW, HP, WV, (size_t)vcu * (NWAVES * 64) + tid, (size_t)G * NWAVES * 64);
          }
            if (BOTH(pb + 7)) GRID_BAR();
        }
        if (EN(8) && IN(pb + 8)) {
          _Pragma("unroll 1") for (int rep = 0; rep < NREP(8); ++rep) { if (rep) GRID_BAR();
            PHASE_TID();
            peer::peer_acc_phase(VQ + (size_t)l * NEXP * D, IDX, WV, FB, bx & 7, (bx >> 3) * NWAVES + wave, (G >> 3) * NWAVES, lane);
          }
            if (BOTH(pb + 8)) GRID_BAR();
        }
        if (EN(9) && IN(pb + 9)) {
          _Pragma("unroll 1") for (int rep = 0; rep < NREP(9); ++rep) { if (rep) GRID_BAR();
            PHASE_TID();
            for (int m = gw; m < M; m += NGW) ln2_row(X1F + (size_t)m * D, FB + (size_t)m * D, args.in[16] + l * D, args.in[17] + l * D, args.out + (size_t)m * D, XB + (size_t)m * D, lane);
          }
            if (BOTH(pb + 9)) GRID_BAR();
        }
    }
#undef IN
#undef BOTH
#undef GRID_BAR
}

extern "C" void kernel_launch(void* const* d_in, const int* in_sizes, int n_in, void* d_out, int out_size, void* d_ws, size_t ws_size, hipStream_t stream) {
    static int grid = 0;
    if (grid == 0) {
        if (n_in != 18 || in_sizes[0] != M * D || out_size != M * D || ws_size < WS_END) { fprintf(stderr, "kernel_launch: unexpected shapes (n_in %d, in0 %d, out %d, ws %zu); nothing launched\n", n_in, n_in > 0 ? in_sizes[0] : -1, out_size, ws_size); grid = -1; return; }
        int dev = 0, cus = 0, per_cu = 0;
        if (hipGetDevice(&dev) != hipSuccess || hipDeviceGetAttribute(&cus, hipDeviceAttributeMultiprocessorCount, dev) != hipSuccess) { grid = -1; return; }
        if (hipFuncSetAttribute((const void*)fwd_kernel, hipFuncAttributeMaxDynamicSharedMemorySize, LDS_BYTES) != hipSuccess) { fprintf(stderr, "kernel_launch: hipFuncSetAttribute failed\n"); grid = -1; return; }
        if (hipOccupancyMaxActiveBlocksPerMultiprocessor(&per_cu, (const void*)fwd_kernel, NWAVES * 64, LDS_BYTES) != hipSuccess || per_cu < 1) fprintf(stderr, "kernel_launch: occupancy query reports %d workgroups per CU\n", per_cu);
        (void)hipGetLastError();
        if (cus < 256) { fprintf(stderr, "kernel_launch: built for a 256-CU device (got %d); nothing launched\n", cus); grid = -1; return; }
        grid = 256;
    }
    if (grid < 0) return;
    if (hipMemsetAsync((char*)d_ws + WS_CTL, 0, CTL_ZERO_BYTES, stream) != hipSuccess) return;
    Args a{};
    for (int i = 0; i < 18; ++i) a.in[i] = (const float*)d_in[i];
    a.out = (float*)d_out; a.ws = (unsigned char*)d_ws;
    if (N_LAUNCHES == 1) { a.ph_lo = 0; a.ph_hi = NPH; hipLaunchKernelGGL(fwd_kernel, dim3(grid), dim3(NWAVES * 64), LDS_BYTES, stream, a); }
    else { for (int p = 0; p < NPH; ++p) { a.ph_lo = p; a.ph_hi = p + 1; hipLaunchKernelGGL(fwd_kernel, dim3(grid), dim3(NWAVES * 64), LDS_BYTES, stream, a); } }
}
```
